# Optimizing an MI355X kernel written in HIP

```python
import math
import jax, jax.numpy as jnp
from jax import lax
import numpy as np

D_MODEL = 1024
BATCH = 16
SEQ = 4096
DEPTH = 1

ATTN_HEADS = D_MODEL // 256
ATTN_HEAD_DIM = 64
ATTN_V_DIM = 2 * ATTN_HEAD_DIM
ATTN_QK_WIDTH = ATTN_HEADS * 2 * ATTN_HEAD_DIM
ATTN_V_WIDTH = ATTN_HEADS * ATTN_V_DIM
Q_BLOCK = 128
NEG_INF = -1e30
REL_BUCKETS = 32
REL_MAX_DISTANCE = 128
SSM_GROUP_CH = 16
SSM_WIDTH = D_MODEL // 2
SSM_GROUPS = SSM_WIDTH // SSM_GROUP_CH
SSM_STATE = 64
SSM_DT_MIN = 1e-3
SSM_DT_MAX = 1e-1
SSM_EIG_MAX_RE = -1e-4
N_BRANCHES = 2
SPLIT_Q = ATTN_QK_WIDTH
SPLIT_K = SPLIT_Q + ATTN_QK_WIDTH
SPLIT_V = SPLIT_K + ATTN_V_WIDTH
SPLIT_U = SPLIT_V + SSM_WIDTH
IN_WIDTH = SPLIT_U + N_BRANCHES * D_MODEL
MOE_GROUPS = 4
MOE_EXPERTS_PER_GROUP = 8
MOE_EXPERTS = MOE_GROUPS * MOE_EXPERTS_PER_GROUP
MOE_TOP_K = 2
MOE_D_FF = D_MODEL // 2
MOE_BLOCK = 256
NORM_EPS = 1e-6
SUBLN_EPS = 1e-5

kernel_name = 'hybrid_diffattn_s5_hiermoe_block'


def rms_norm(x, g, eps=NORM_EPS):
    xf = x.astype(jnp.float32)
    y = xf * lax.rsqrt(jnp.mean(xf * xf, axis=-1, keepdims=True) + eps)
    return (y * g.astype(jnp.float32)).astype(x.dtype)


def modulate(h, shift, scale):
    return h * (1 + scale[:, None, :]) + shift[:, None, :]


def rel_bucket(dist):
    max_exact = REL_BUCKETS // 2
    n = jnp.maximum(dist, 0)
    log_ratio = jnp.log(jnp.maximum(n, 1).astype(jnp.float32) / max_exact) / math.log(REL_MAX_DISTANCE / max_exact)
    large = max_exact + (log_ratio * (REL_BUCKETS - max_exact)).astype(jnp.int32)
    large = jnp.minimum(large, REL_BUCKETS - 1)
    return jnp.where(n < max_exact, n, large)


def diff_attention(q, k, v, rel_bias, lq1, lk1, lq2, lk2, subln_g, lambda_init):
    B_, S_ = q.shape[0], q.shape[1]
    f32 = jnp.float32
    lam = (jnp.exp(jnp.sum(lq1.astype(f32) * lk1.astype(f32)))
           - jnp.exp(jnp.sum(lq2.astype(f32) * lk2.astype(f32))) + lambda_init)
    qT = jnp.transpose(q, (0, 2, 3, 1, 4)) * (ATTN_HEAD_DIM ** -0.5)
    kT = jnp.transpose(k, (0, 2, 3, 1, 4))
    vT = jnp.transpose(v, (0, 2, 1, 3))
    outs = []
    for blk in range(S_ // Q_BLOCK):
        q0 = blk * Q_BLOCK
        q1 = q0 + Q_BLOCK
        dist = jnp.arange(q0, q1)[:, None] - jnp.arange(q1)[None, :]
        bias = jnp.transpose(rel_bias[rel_bucket(dist)], (2, 0, 1)).astype(f32)
        s = jnp.einsum('bhmqd,bhmkd->bhmqk', qT[:, :, :, q0:q1], kT[:, :, :, :q1]).astype(f32)
        s = jnp.where(dist >= 0, s + bias[None, :, None], NEG_INF)
        p = jax.nn.softmax(s, axis=-1)
        w = p[:, :, 0] - lam * p[:, :, 1]
        outs.append(jnp.einsum('bhqk,bhkd->bhqd', w.astype(vT.dtype), vT[:, :, :q1]))
    o = jnp.concatenate(outs, axis=2)
    o = rms_norm(o, subln_g, SUBLN_EPS) * (1 - lambda_init)
    return jnp.transpose(o, (0, 2, 1, 3)).reshape(B_, S_, ATTN_V_WIDTH)


def _complex_linear_combine(e1, e2):
    a1r, a1i, b1r, b1i = e1
    a2r, a2i, b2r, b2i = e2
    return (a2r * a1r - a2i * a1i,
            a2r * a1i + a2i * a1r,
            a2r * b1r - a2i * b1i + b2r,
            a2r * b1i + a2i * b1r + b2i)


def s5_branch(u, lam_re, lam_im, log_step, b_re, b_im, c_re, c_im, d_skip, w_glu):
    B_, S_ = u.shape[0], u.shape[1]
    f32 = jnp.float32
    ug = u.astype(f32).reshape(B_, S_, SSM_GROUPS, SSM_GROUP_CH)
    lr = jnp.minimum(lam_re.astype(f32), SSM_EIG_MAX_RE)
    li = lam_im.astype(f32)
    step = jnp.exp(log_step.astype(f32))[:, None]
    mag = jnp.exp(lr * step)
    ang = li * step
    a_re = mag * jnp.cos(ang)
    a_im = mag * jnp.sin(ang)
    den = lr * lr + li * li
    num_re = a_re - 1.0
    coef_re = (num_re * lr + a_im * li) / den
    coef_im = (a_im * lr - num_re * li) / den
    br = b_re.astype(f32)
    bi = b_im.astype(f32)
    bb_re = coef_re[..., None] * br - coef_im[..., None] * bi
    bb_im = coef_re[..., None] * bi + coef_im[..., None] * br
    bu_re = jnp.einsum('bsgh,gph->bsgp', ug, bb_re)
    bu_im = jnp.einsum('bsgh,gph->bsgp', ug, bb_im)
    a_re_s = jnp.broadcast_to(a_re, (S_,) + a_re.shape)
    a_im_s = jnp.broadcast_to(a_im, (S_,) + a_im.shape)

    def scan_one(bre, bim):
        _, _, xr, xi = lax.associative_scan(_complex_linear_combine, (a_re_s, a_im_s, bre, bim), axis=0)
        return xr, xi

    xr, xi = jax.vmap(scan_one)(bu_re, bu_im)
    y = (jnp.einsum('bsgp,ghp->bsgh', xr, c_re.astype(f32))
         - jnp.einsum('bsgp,ghp->bsgh', xi, c_im.astype(f32))
         + d_skip.astype(f32) * ug)
    y = jax.nn.gelu(y.reshape(B_, S_, SSM_WIDTH)).astype(u.dtype)
    gl = y @ w_glu
    return gl[..., :SSM_WIDTH] * jax.nn.sigmoid(gl[..., SSM_WIDTH:])


def hier_moe(h, w_rg, b_rg, w_re, b_re, w_e_in, w_e_out):
    B_, S_, D = h.shape
    T = B_ * S_
    xt = h.reshape(T, D)
    lg = (xt @ w_rg + b_rg).astype(jnp.float32)
    pg = jax.nn.softmax(lg, axis=-1)
    grp = jnp.argmax(lg, axis=-1)
    p_grp = jnp.take_along_axis(pg, grp[:, None], axis=-1)
    le_all = (jnp.einsum('td,gde->tge', xt, w_re) + b_re).astype(jnp.float32)
    le = jnp.take_along_axis(le_all, grp[:, None, None], axis=1)[:, 0]
    top_v, top_i = lax.top_k(le, MOE_TOP_K)
    comb = p_grp * jax.nn.softmax(top_v, axis=-1)
    eid = grp[:, None] * MOE_EXPERTS_PER_GROUP + top_i
    n_assign = T * MOE_TOP_K
    n_pad = (-(-n_assign // MOE_BLOCK) + MOE_EXPERTS) * MOE_BLOCK
    e_flat = eid.reshape(n_assign).astype(jnp.int32)
    w_flat = comb.reshape(n_assign)
    tok_flat = jnp.repeat(jnp.arange(T, dtype=jnp.int32), MOE_TOP_K)
    order = jnp.argsort(e_flat)
    e_sorted = e_flat[order]
    counts = jax.ops.segment_sum(jnp.ones_like(e_flat), e_flat, num_segments=MOE_EXPERTS)
    starts = jnp.cumsum(counts) - counts
    padded = ((counts + MOE_BLOCK - 1) // MOE_BLOCK) * MOE_BLOCK
    pends = jnp.cumsum(padded)
    pstarts = pends - padded
    dest = pstarts[e_sorted] + (jnp.arange(n_assign, dtype=jnp.int32) - starts[e_sorted])
    row_tok = jnp.full((n_pad,), T, jnp.int32).at[dest].set(tok_flat[order])
    row_w = jnp.zeros((n_pad,), jnp.float32).at[dest].set(w_flat[order])
    n_blocks = n_pad // MOE_BLOCK
    block_start = jnp.arange(n_blocks, dtype=jnp.int32) * MOE_BLOCK
    block_e = jnp.minimum(jnp.searchsorted(pends, block_start, side='right'), MOE_EXPERTS - 1)
    x_pad = jnp.concatenate([xt, jnp.zeros((1, D), xt.dtype)], axis=0)
    xs = x_pad[row_tok].reshape(n_blocks, MOE_BLOCK, D)

    def expert_block(args):
        xb, e = args
        hid = xb @ w_e_in[e]
        a, g = jnp.split(hid, 2, axis=-1)
        return (jax.nn.silu(a) * g) @ w_e_out[e]

    ys = lax.map(expert_block, (xs, block_e)).reshape(n_pad, D)
    out = jnp.zeros((T + 1, D), h.dtype).at[row_tok].add(ys * row_w[:, None].astype(ys.dtype))
    return out[:T].reshape(B_, S_, D)


def setup_inputs(seed: int = 0) -> dict:
    key = jax.random.key(seed)
    ks = jax.random.split(key, 32)
    f32 = jnp.float32

    def nrm(k, shape, scale):
        return jax.random.normal(k, shape, f32) * scale

    G, P, H = SSM_GROUPS, SSM_STATE, SSM_GROUP_CH
    n = jnp.arange(SSM_STATE, dtype=f32)
    return {
        'x': nrm(ks[0], (BATCH, SEQ, D_MODEL), 1.0),
        'c': nrm(ks[1], (BATCH, D_MODEL), 1.0),
        'w_ada': nrm(ks[2], (DEPTH, D_MODEL, 6 * D_MODEL), 0.5 * D_MODEL ** -0.5),
        'b_ada': nrm(ks[3], (DEPTH, 6 * D_MODEL), 0.01),
        'norm1_g': 1.0 + nrm(ks[4], (DEPTH, D_MODEL), 0.01),
        'w_in': nrm(ks[5], (DEPTH, D_MODEL, IN_WIDTH), D_MODEL ** -0.5),
        'rel_bias': nrm(ks[6], (REL_BUCKETS, ATTN_HEADS), 0.5),
        'lambda_q1': nrm(ks[7], (DEPTH, ATTN_HEAD_DIM), 0.1),
        'lambda_k1': nrm(ks[8], (DEPTH, ATTN_HEAD_DIM), 0.1),
        'lambda_q2': nrm(ks[9], (DEPTH, ATTN_HEAD_DIM), 0.1),
        'lambda_k2': nrm(ks[10], (DEPTH, ATTN_HEAD_DIM), 0.1),
        'subln_g': 1.0 + nrm(ks[11], (DEPTH, ATTN_V_DIM), 0.01),
        'ssm_lambda_re': -0.5 + nrm(ks[12], (DEPTH, G, P), 0.01),
        'ssm_lambda_im': math.pi * n + nrm(ks[13], (DEPTH, G, P), 0.01),
        'ssm_log_step': jax.random.uniform(ks[14], (DEPTH, G), f32, math.log(SSM_DT_MIN), math.log(SSM_DT_MAX)),
        'ssm_b_re': nrm(ks[15], (DEPTH, G, P, H), (2 * H) ** -0.5),
        'ssm_b_im': nrm(ks[16], (DEPTH, G, P, H), (2 * H) ** -0.5),
        'ssm_c_re': nrm(ks[17], (DEPTH, G, H, P), P ** -0.5),
        'ssm_c_im': nrm(ks[18], (DEPTH, G, H, P), P ** -0.5),
        'ssm_d': nrm(ks[19], (DEPTH, G, H), 1.0),
        'w_glu': nrm(ks[20], (DEPTH, SSM_WIDTH, 2 * SSM_WIDTH), SSM_WIDTH ** -0.5),
        'w_proj_attn': nrm(ks[21], (DEPTH, ATTN_V_WIDTH, D_MODEL), ATTN_V_WIDTH ** -0.5),
        'w_proj_ssm': nrm(ks[22], (DEPTH, SSM_WIDTH, D_MODEL), SSM_WIDTH ** -0.5),
        'w_out': nrm(ks[23], (DEPTH, D_MODEL, D_MODEL), D_MODEL ** -0.5),
        'norm2_g': 1.0 + nrm(ks[24], (DEPTH, D_MODEL), 0.01),
        'w_router_group': nrm(ks[25], (DEPTH, D_MODEL, MOE_GROUPS), D_MODEL ** -0.5),
        'b_router_group': nrm(ks[26], (DEPTH, MOE_GROUPS), 0.01),
        'w_router_expert': nrm(ks[27], (DEPTH, MOE_GROUPS, D_MODEL, MOE_EXPERTS_PER_GROUP), D_MODEL ** -0.5),
        'b_router_expert': nrm(ks[28], (DEPTH, MOE_GROUPS, MOE_EXPERTS_PER_GROUP), 0.01),
        'w_expert_in': nrm(ks[29], (DEPTH, MOE_EXPERTS, D_MODEL, 2 * MOE_D_FF), D_MODEL ** -0.5),
        'w_expert_out': nrm(ks[30], (DEPTH, MOE_EXPERTS, MOE_D_FF, D_MODEL), MOE_D_FF ** -0.5),
        'final_g': 1.0 + nrm(ks[31], (D_MODEL,), 0.01),
    }


def reference(x, c, w_ada, b_ada, norm1_g, w_in, rel_bias, lambda_q1, lambda_k1, lambda_q2, lambda_k2,
              subln_g, ssm_lambda_re, ssm_lambda_im, ssm_log_step, ssm_b_re, ssm_b_im, ssm_c_re, ssm_c_im,
              ssm_d, w_glu, w_proj_attn, w_proj_ssm, w_out, norm2_g, w_router_group, b_router_group,
              w_router_expert, b_router_expert, w_expert_in, w_expert_out, final_g):
    B_, S_ = x.shape[0], x.shape[1]
    c_act = jax.nn.silu(c)
    for layer in range(DEPTH):
        lambda_init = 0.8 - 0.6 * math.exp(-0.3 * layer)
        mod = c_act @ w_ada[layer] + b_ada[layer]
        shift1, scale1, gate1, shift2, scale2, gate2 = jnp.split(mod, 6, axis=-1)
        h = modulate(rms_norm(x, norm1_g[layer]), shift1, scale1)
        proj = h @ w_in[layer]
        q, k, v, u, gates = jnp.split(proj, [SPLIT_Q, SPLIT_K, SPLIT_V, SPLIT_U], axis=-1)
        y_attn = diff_attention(
            q.reshape(B_, S_, ATTN_HEADS, 2, ATTN_HEAD_DIM),
            k.reshape(B_, S_, ATTN_HEADS, 2, ATTN_HEAD_DIM),
            v.reshape(B_, S_, ATTN_HEADS, ATTN_V_DIM),
            rel_bias, lambda_q1[layer], lambda_k1[layer], lambda_q2[layer], lambda_k2[layer],
            subln_g[layer], lambda_init)
        y_ssm = s5_branch(u, ssm_lambda_re[layer], ssm_lambda_im[layer], ssm_log_step[layer],
                          ssm_b_re[layer], ssm_b_im[layer], ssm_c_re[layer], ssm_c_im[layer],
                          ssm_d[layer], w_glu[layer])
        g_attn, g_ssm = jnp.split(jax.nn.sigmoid(gates), 2, axis=-1)
        merged = g_attn * (y_attn @ w_proj_attn[layer]) + g_ssm * (y_ssm @ w_proj_ssm[layer])
        x = x + gate1[:, None, :] * (merged @ w_out[layer])
        h = modulate(rms_norm(x, norm2_g[layer]), shift2, scale2)
        x = x + gate2[:, None, :] * hier_moe(h, w_router_group[layer], b_router_group[layer],
                                             w_router_expert[layer], b_router_expert[layer],
                                             w_expert_in[layer], w_expert_out[layer])
    return rms_norm(x, final_g)
```

```cpp
#include <hip/hip_runtime.h>
#include <hip/hip_bf16.h>
#include <cstdio>
#include <cstdint>
#include <cmath>

#ifndef MK_PER_PHASE
#define MK_PER_PHASE 0
#endif

namespace pg8 {
#define PG8_LAS __attribute__((address_space(3)))
typedef unsigned short bf16_t;
typedef short bf16x8 __attribute__((ext_vector_type(8)));
typedef float f32x4 __attribute__((ext_vector_type(4)));
typedef unsigned u32x4 __attribute__((ext_vector_type(4)));
constexpr int BM = 256, BK = 64, HALF = 128, HTB = HALF * BK * 2  , STAGE_BYTES = 8 * HTB, NXCD = 8, WGM = 8;

__host__ __device__ __forceinline__ int lds_byte(int r, int c) { const int st = (r >> 4) * 2 + (c >> 5), rr = r & 15, cc = c & 31, ob = rr * 64 + cc * 2; return st * 1024 + (ob ^ (((ob >> 9) & 1) << 5)); }
__host__ __device__ __forceinline__ void stage_rc(int b, int& R, int& C) { const int st = b / 1024, sb = b % 1024, swz = sb ^ (((sb >> 9) & 1) << 5); R = (st >> 1) * 16 + swz / 64; C = (st & 1) * 32 + (swz % 64) / 2; }
__host__ __device__ __forceinline__ int perm32(int rho) { const int n = rho >> 4, i = rho & 15; return 8 * (i >> 2) + 4 * n + (i & 3); }

struct Unit { int pm, pn, pc; };
struct Gemm { const bf16_t* A; const bf16_t* Bt; int K; };

struct StaticOrder {
    int nM, nN, nwg, G, c;
    __host__ __device__ void init(int M, int N, int G_, int c_) { nM = M / BM; nN = N / BM; nwg = nM * nN; G = G_; c = c_; }
    __host__ __device__ bool next(int i, Unit& u) const {
        const long L = (long)i * G + c; if (L >= nwg) return false;
        int wgid = (int)L; { const int q = nwg / NXCD, r = nwg % NXCD, xcd = wgid % NXCD, off = wgid / NXCD; wgid = (xcd < r ? xcd * (q + 1) : r * (q + 1) + (xcd - r) * q) + off; }
        const int nig = WGM * nN, gid = wgid / nig, fm = gid * WGM, gsz = (nM - fm) < WGM ? (nM - fm) : WGM;
        u.pm = fm + ((wgid % nig) % gsz); u.pn = (wgid % nig) / gsz; u.pc = u.pn; return true;
    }
    __device__ __forceinline__ void arows(const Unit& u, int, int R0, int R1, unsigned (&r)[2][2]) const {
        r[0][0] = u.pm * BM + R0; r[0][1] = u.pm * BM + R1; r[1][0] = u.pm * BM + HALF + R0; r[1][1] = u.pm * BM + HALF + R1; }
};
struct ExpertOrder {
    const PG8_LAS int* tile_e; const PG8_LAS int* rowtab; int MT, G, c; bool gather;
    __device__ __forceinline__ bool next(int i, Unit& u) const {
        const int L = i * G + c; if (L >= MT * 4) return false;
        const int mt = L >> 2, nt = L & 3; const int e = tile_e[mt]; u.pm = mt; u.pn = e * 4 + nt; u.pc = nt; return true; }
    __device__ __forceinline__ void arows(const Unit& u, int ui, int R0, int R1, unsigned (&r)[2][2]) const {
        if (gather) { const PG8_LAS int* t = rowtab + ui * BM; r[0][0] = (unsigned)t[R0]; r[0][1] = (unsigned)t[R1]; r[1][0] = (unsigned)t[HALF + R0]; r[1][1] = (unsigned)t[HALF + R1]; }
        else { r[0][0] = u.pm * BM + R0; r[0][1] = u.pm * BM + R1; r[1][0] = u.pm * BM + HALF + R0; r[1][1] = u.pm * BM + HALF + R1; } }
};

__device__ __forceinline__ unsigned cvt_pk_bf16(float lo, float hi) { unsigned r; asm volatile("v_cvt_pk_bf16_f32 %0, %1, %2" : "=v"(r) : "v"(lo), "v"(hi)); return r; }
__device__ __forceinline__ float bf_lo(unsigned w) { return __uint_as_float(w << 16); }
__device__ __forceinline__ float bf_hi(unsigned w) { return __uint_as_float(w & 0xffff0000u); }
__device__ __forceinline__ float sigm(float x) { return __builtin_amdgcn_rcpf(1.f + __builtin_amdgcn_exp2f(-1.4426950408889634f * x)); }
__device__ __forceinline__ u32x4 pack8(const f32x4& v0, const f32x4& v1) { u32x4 w; w.x = cvt_pk_bf16(v0[0], v0[1]); w.y = cvt_pk_bf16(v0[2], v0[3]); w.z = cvt_pk_bf16(v1[0], v1[1]); w.w = cvt_pk_bf16(v1[2], v1[3]); return w; }

struct EpiInProj { static constexpr bool PERM = true;
    bf16_t* qkvu; bf16_t* gates; float qscale;
    __device__ __forceinline__ void operator()(const f32x4 (&acc)[2][2][4][2], const Unit& u, int wr, int wc, int fr, int fq) const {
        const int row0 = u.pm * BM + wr * 64 + fr; const bool isg = u.pc >= 8;
        bf16_t* base = isg ? gates : qkvu; const int col0 = (u.pc & 7) * BM + wc * 32 + 8 * fq; const float sc = (u.pc < 2) ? qscale : 1.f;
#pragma unroll
        for (int ai = 0; ai < 2; ++ai)
#pragma unroll
            for (int m = 0; m < 4; ++m) { bf16_t* rowp = base + (size_t)(row0 + ai * HALF + m * 16) * 2048 + col0;
#pragma unroll
                for (int bj = 0; bj < 2; ++bj) { f32x4 v0 = acc[ai][bj][m][0], v1 = acc[ai][bj][m][1];
                    if (isg) {
#pragma unroll
                        for (int i = 0; i < 4; ++i) { v0[i] = sigm(v0[i]); v1[i] = sigm(v1[i]); } }
                    else { v0 = v0 * sc; v1 = v1 * sc; }
                    *(u32x4*)(rowp + bj * HALF) = pack8(v0, v1); } }
    }
};
template <int MODE> struct EpiGate { static constexpr bool PERM = true;
    bf16_t* O; int ldc;
    __device__ __forceinline__ void operator()(const f32x4 (&acc)[2][2][4][2], const Unit& u, int wr, int wc, int fr, int fq) const {
        const int row0 = u.pm * BM + wr * 64 + fr; const int col0 = u.pc * HALF + wc * 32 + 8 * fq;
#pragma unroll
        for (int ai = 0; ai < 2; ++ai)
#pragma unroll
            for (int m = 0; m < 4; ++m) { f32x4 r0, r1;
#pragma unroll
                for (int i = 0; i < 4; ++i) { const float a0 = acc[ai][0][m][0][i], a1 = acc[ai][0][m][1][i], g0 = acc[ai][1][m][0][i], g1 = acc[ai][1][m][1][i];
                    if (MODE == 0) { r0[i] = a0 * sigm(g0); r1[i] = a1 * sigm(g1); } else { r0[i] = a0 * sigm(a0) * g0; r1[i] = a1 * sigm(a1) * g1; } }
                *(u32x4*)(O + (size_t)(row0 + ai * HALF + m * 16) * ldc + col0) = pack8(r0, r1); }
    }
};
struct EpiGateMul { static constexpr bool PERM = true;
    const bf16_t* gates; int goff; const bf16_t* addend; bf16_t* out;
    __device__ __forceinline__ void operator()(const f32x4 (&acc)[2][2][4][2], const Unit& u, int wr, int wc, int fr, int fq) const {
        const int row0 = u.pm * BM + wr * 64 + fr; const int col0 = u.pc * BM + wc * 32 + 8 * fq;
#pragma unroll
        for (int ai = 0; ai < 2; ++ai)
#pragma unroll
            for (int m = 0; m < 4; ++m) { const size_t r = (size_t)(row0 + ai * HALF + m * 16);
#pragma unroll
                for (int bj = 0; bj < 2; ++bj) { const int c = col0 + bj * HALF;
                    const u32x4 gw = *(const u32x4*)(gates + r * 2048 + goff + c);
                    f32x4 v0 = acc[ai][bj][m][0], v1 = acc[ai][bj][m][1];
                    v0[0] *= bf_lo(gw.x); v0[1] *= bf_hi(gw.x); v0[2] *= bf_lo(gw.y); v0[3] *= bf_hi(gw.y);
                    v1[0] *= bf_lo(gw.z); v1[1] *= bf_hi(gw.z); v1[2] *= bf_lo(gw.w); v1[3] *= bf_hi(gw.w);
                    if (addend) { const u32x4 aw = *(const u32x4*)(addend + r * 1024 + c);
                        v0[0] += bf_lo(aw.x); v0[1] += bf_hi(aw.x); v0[2] += bf_lo(aw.y); v0[3] += bf_hi(aw.y);
                        v1[0] += bf_lo(aw.z); v1[1] += bf_hi(aw.z); v1[2] += bf_lo(aw.w); v1[3] += bf_hi(aw.w); }
                    *(u32x4*)(out + r * 1024 + c) = pack8(v0, v1); } }
    }
};
struct EpiResid { static constexpr bool PERM = true;
    const float* x; const float* mod; float* x1;
    __device__ __forceinline__ void operator()(const f32x4 (&acc)[2][2][4][2], const Unit& u, int wr, int wc, int fr, int fq) const {
        const int row0 = u.pm * BM + wr * 64 + fr; const int col0 = u.pc * BM + wc * 32 + 8 * fq; const float* gp = mod + (size_t)(u.pm >> 4) * 6144 + 2048;
        f32x4 gv[2][2];
#pragma unroll
        for (int bj = 0; bj < 2; ++bj) { gv[bj][0] = *(const f32x4*)(gp + col0 + bj * HALF); gv[bj][1] = *(const f32x4*)(gp + col0 + bj * HALF + 4); }
#pragma unroll
        for (int ai = 0; ai < 2; ++ai)
#pragma unroll
            for (int m = 0; m < 4; ++m) { const size_t off = (size_t)(row0 + ai * HALF + m * 16) * 1024 + col0;
#pragma unroll
                for (int bj = 0; bj < 2; ++bj) { const f32x4 x0 = *(const f32x4*)(x + off + bj * HALF), x1v = *(const f32x4*)(x + off + bj * HALF + 4);
                    *(f32x4*)(x1 + off + bj * HALF) = x0 + gv[bj][0] * acc[ai][bj][m][0]; *(f32x4*)(x1 + off + bj * HALF + 4) = x1v + gv[bj][1] * acc[ai][bj][m][1]; } }
    }
};
struct EpiRouter { static constexpr bool PERM = true;
    float* logits;
    __device__ __forceinline__ void operator()(const f32x4 (&acc)[2][2][4][2], const Unit& u, int wr, int wc, int fr, int fq) const {
        if (wc >= 2) return;
        const int row0 = u.pm * BM + wr * 64 + fr; const int col0 = wc * 32 + 8 * fq;
#pragma unroll
        for (int ai = 0; ai < 2; ++ai)
#pragma unroll
            for (int m = 0; m < 4; ++m) { float* p = logits + (size_t)(row0 + ai * HALF + m * 16) * 64 + col0; *(f32x4*)p = acc[ai][0][m][0]; *(f32x4*)(p + 4) = acc[ai][0][m][1]; }
    }
};
struct EpiPlain { static constexpr bool PERM = true;
    bf16_t* O; int ldc;
    __device__ __forceinline__ void operator()(const f32x4 (&acc)[2][2][4][2], const Unit& u, int wr, int wc, int fr, int fq) const {
        const int row0 = u.pm * BM + wr * 64 + fr; const int col0 = u.pc * BM + wc * 32 + 8 * fq;
#pragma unroll
        for (int ai = 0; ai < 2; ++ai)
#pragma unroll
            for (int m = 0; m < 4; ++m) { bf16_t* rowp = O + (size_t)(row0 + ai * HALF + m * 16) * ldc + col0;
#pragma unroll
                for (int bj = 0; bj < 2; ++bj) *(u32x4*)(rowp + bj * HALF) = pack8(acc[ai][bj][m][0], acc[ai][bj][m][1]); }
    }
};

template <class Epi, class Sched, bool ALIGN_EPI>
__device__ __forceinline__ void gemm_phase(PG8_LAS unsigned char* lds, const Gemm g, const Sched& S, const Epi& E) {
    const int tid = threadIdx.x, wid = __builtin_amdgcn_readfirstlane(tid >> 6), lane = tid & 63, wr = wid >> 2, wc = wid & 3, fr = lane & 15, fq = lane >> 4;
    const int K = g.K, nt = K / BK;
    int Rr[2], Cc[2]; unsigned voffB[2];
#pragma unroll
    for (int i = 0; i < 2; ++i) { int R, C; stage_rc(tid * 16 + i * 8192, R, C); const int Rb = Epi::PERM ? ((R & ~31) + perm32(R & 31)) : R;
        Rr[i] = R; Cc[i] = C; voffB[i] = (unsigned)(Rb * K + C) * 2u; }
    const size_t kstep = (size_t)(BK * 2);
    const size_t hstep = (size_t)HALF * K * 2;
    const size_t tstep = 2 * hstep;
    const unsigned ldsw = (unsigned)wid * 1024u;
    const int aoff = lds_byte(wr * 64 + fr, fq * 8), boff = lds_byte(wc * 32 + fr, fq * 8);
#define PG8_SA(b, h) (((b) * 2 + (h)) * HTB)
#define PG8_SB(b, h) ((4 + (b) * 2 + (h)) * HTB)
#define PG8_STAGE(bufoff, gbase, voff) do { _Pragma("unroll") for (int _i = 0; _i < 2; ++_i) \
        __builtin_amdgcn_global_load_lds((const unsigned*)((const char*)(gbase) + (voff)[_i]), (PG8_LAS unsigned*)(lds + (bufoff) + ldsw + _i * 8192), 16, 0, 0); } while (0)
#define PG8_LDA(dst, b, h) do { _Pragma("unroll") for (int m = 0; m < 4; ++m) _Pragma("unroll") for (int k = 0; k < 2; ++k) dst[m][k] = *(const PG8_LAS bf16x8*)(lds + PG8_SA(b, h) + aoff + m * 2048 + k * 1024); } while (0)
#define PG8_LDB(dst, b, h) do { _Pragma("unroll") for (int n = 0; n < 2; ++n) _Pragma("unroll") for (int k = 0; k < 2; ++k) dst[n][k] = *(const PG8_LAS bf16x8*)(lds + PG8_SB(b, h) + boff + n * 2048 + k * 1024); } while (0)
#define PG8_MMA(ai, bj, At, Bt) do { __builtin_amdgcn_s_setprio(1); _Pragma("unroll") for (int m = 0; m < 4; ++m) _Pragma("unroll") for (int n = 0; n < 2; ++n) _Pragma("unroll") for (int k = 0; k < 2; ++k) \
        acc[ai][bj][m][n] = __builtin_amdgcn_mfma_f32_16x16x32_bf16(Bt[n][k], At[m][k], acc[ai][bj][m][n], 0, 0, 0); __builtin_amdgcn_s_setprio(0); } while (0)
#define PG8_WAIT_V(n) asm volatile("s_waitcnt vmcnt(" #n ")" ::: "memory")
#define PG8_WAIT_L(n) asm volatile("s_waitcnt lgkmcnt(" #n ")" ::: "memory")
#define PG8_BAR __builtin_amdgcn_s_barrier()
#define PG8_SCHED __builtin_amdgcn_sched_barrier(0)
#define PG8_MKOFF(u_, ui_, v_) do { unsigned r_[2][2]; S.arows(u_, ui_, Rr[0], Rr[1], r_); _Pragma("unroll") for (int h_ = 0; h_ < 2; ++h_) _Pragma("unroll") for (int i_ = 0; i_ < 2; ++i_) \
        v_[h_][i_] = (r_[h_][i_] * (unsigned)K + (unsigned)Cc[i_]) * 2u; } while (0)
    Unit cur, nxt; int ui = 0;
    if (!S.next(0, cur)) return;
    unsigned vc[2][2], vn[2][2];
    PG8_MKOFF(cur, 0, vc);
    f32x4 acc[2][2][4][2];
#pragma unroll
    for (int a = 0; a < 2; ++a)
#pragma unroll
        for (int b = 0; b < 2; ++b)
#pragma unroll
            for (int m = 0; m < 4; ++m)
#pragma unroll
                for (int n = 0; n < 2; ++n) acc[a][b][m][n] = (f32x4){0.f, 0.f, 0.f, 0.f};
    bf16x8 At[4][2], B0[2][2], B1[2][2];
    const char* Ab = (const char*)g.A; const char* cB = (const char*)g.Bt + (size_t)cur.pn * tstep;
    PG8_STAGE(PG8_SB(0, 0), cB, voffB); PG8_STAGE(PG8_SB(0, 1), cB + hstep, voffB); PG8_STAGE(PG8_SA(0, 0), Ab, vc[0]); PG8_STAGE(PG8_SA(0, 1), Ab, vc[1]);
    if (wr == 1) PG8_BAR;
    PG8_WAIT_V(2); PG8_BAR;
    PG8_STAGE(PG8_SB(1, 0), cB + kstep, voffB); PG8_STAGE(PG8_SA(1, 0), Ab + kstep, vc[0]); PG8_STAGE(PG8_SB(1, 1), cB + hstep + kstep, voffB);
    PG8_WAIT_V(6); PG8_BAR;
    for (;;) {
        const bool has_next = S.next(ui + 1, nxt);
        if (has_next) { PG8_MKOFF(nxt, ui + 1, vn); } else { vn[0][0] = vc[0][0]; vn[0][1] = vc[0][1]; vn[1][0] = vc[1][0]; vn[1][1] = vc[1][1]; }
        const char* nB = has_next ? (const char*)g.Bt + (size_t)nxt.pn * tstep : cB;
        for (int t = 0; t < nt; t += 2) {
            const bool last = (t == nt - 2);
            const char* a1 = Ab + (size_t)(t + 1) * kstep;
            const char* a2 = last ? Ab : Ab + (size_t)(t + 2) * kstep; const char* b2 = last ? nB : cB + (size_t)(t + 2) * kstep;
            const char* a3 = a2 + kstep; const char* b3 = b2 + kstep;
            unsigned vs[2][2];
#pragma unroll
            for (int h = 0; h < 2; ++h)
#pragma unroll
                for (int i = 0; i < 2; ++i) vs[h][i] = last ? vn[h][i] : vc[h][i];
            PG8_LDB(B0, 0, 0); PG8_LDB(B1, 0, 1); PG8_SCHED; PG8_LDA(At, 0, 0); PG8_STAGE(PG8_SA(1, 1), a1, vc[1]);
            PG8_WAIT_V(8); PG8_WAIT_L(0); PG8_BAR; PG8_MMA(0, 0, At, B0); PG8_MMA(0, 1, At, B1); PG8_BAR; PG8_SCHED;
            PG8_LDA(At, 0, 1); PG8_STAGE(PG8_SB(0, 0), b2, voffB); PG8_STAGE(PG8_SB(0, 1), b2 + hstep, voffB); PG8_STAGE(PG8_SA(0, 0), a2, vs[0]);
            PG8_WAIT_V(8); PG8_WAIT_L(0); PG8_BAR; PG8_MMA(1, 0, At, B0); PG8_MMA(1, 1, At, B1); PG8_BAR; PG8_SCHED;
            PG8_LDB(B0, 1, 0); PG8_LDB(B1, 1, 1); PG8_SCHED; PG8_LDA(At, 1, 0); PG8_STAGE(PG8_SA(0, 1), a2, vs[1]);
            PG8_WAIT_V(8); PG8_WAIT_L(0); PG8_BAR; PG8_MMA(0, 0, At, B0); PG8_MMA(0, 1, At, B1); PG8_BAR; PG8_SCHED;
            PG8_LDA(At, 1, 1); PG8_STAGE(PG8_SB(1, 0), b3, voffB); PG8_STAGE(PG8_SB(1, 1), b3 + hstep, voffB); PG8_STAGE(PG8_SA(1, 0), a3, vs[0]);
            PG8_WAIT_V(8); PG8_WAIT_L(0); PG8_BAR; PG8_MMA(1, 0, At, B0); PG8_MMA(1, 1, At, B1); PG8_BAR; PG8_SCHED;
        }
        if constexpr (ALIGN_EPI) { if (wr == 0) PG8_BAR; }
        E(acc, cur, wr, wc, fr, fq);
        if (!has_next) break;
#pragma unroll
        for (int a = 0; a < 2; ++a)
#pragma unroll
            for (int b = 0; b < 2; ++b)
#pragma unroll
                for (int m = 0; m < 4; ++m)
#pragma unroll
                    for (int n = 0; n < 2; ++n) acc[a][b][m][n] = (f32x4){0.f, 0.f, 0.f, 0.f};
        cur = nxt; cB = nB; ++ui;
        vc[0][0] = vn[0][0]; vc[0][1] = vn[0][1]; vc[1][0] = vn[1][0]; vc[1][1] = vn[1][1];
        if constexpr (ALIGN_EPI) { if (wr == 1) PG8_BAR; }
    }
    PG8_WAIT_V(0);
    if constexpr (!ALIGN_EPI) { if (wr == 0) PG8_BAR; }
    PG8_BAR;
#undef PG8_SA
#undef PG8_SB
#undef PG8_STAGE
#undef PG8_LDA
#undef PG8_LDB
#undef PG8_MMA
#undef PG8_WAIT_V
#undef PG8_WAIT_L
#undef PG8_BAR
#undef PG8_SCHED
#undef PG8_MKOFF
}
}

namespace attn_body {
using bf16=__hip_bfloat16;
using bf16x8=__attribute__((ext_vector_type(8)))short;
using s16x4=__attribute__((ext_vector_type(4)))short;
using f32x16=__attribute__((ext_vector_type(16)))float;
using u32x4=__attribute__((ext_vector_type(4)))unsigned;
constexpr int BATCH=16,NHEAD=16,SEQ=4096,D=64,DM=NHEAD*D;
constexpr int PQ=2048;
constexpr int TABN=640;
constexpr int NW=8,QBLK=32,QB=QBLK*NW,KVBLK=64,NQB=SEQ/QB;
constexpr int ATTN_PITCH=DM, ATTN_UNIT_ROWS=QB;
__device__ __forceinline__ int crow(int r,int hi){return (r&3)+8*(r>>2)+4*hi;}
#define SBAR() __builtin_amdgcn_sched_barrier(0)
typedef __attribute__((address_space(3))) const float* lds_fptr;
__device__ __forceinline__ void cmask(f32x16&p0,f32x16&p1,int dt,int qrel,int hi,lds_fptr tab){
  lds_fptr t=tab+(64*dt+qrel-4*hi+255-59);
  #pragma unroll
  for(int r=0;r<16;++r){p0[r]+=t[59-((r&3)+8*(r>>2))]; p1[r]+=t[27-((r&3)+8*(r>>2))];}
}
constexpr int NSLOT=3, SLOTB=8192;
constexpr int LDS_K=0, LDS_V=NSLOT*SLOTB, LDS_WS=2*NSLOT*SLOTB, LDS_OST=LDS_WS+NW*64*4, LDS_BYTES=LDS_OST+NW*4096;
constexpr float C2=0.125f*1.4426950408889634f;
__device__ __forceinline__ void glds16(const void*gsrc,unsigned lds_dst){unsigned keep;
  asm volatile("s_mov_b32 %0, m0\n\ts_mov_b32 m0, %2\n\ts_nop 0\n\tglobal_load_lds_dwordx4 %1, off\n\ts_mov_b32 m0, %0":"=&s"(keep):"v"(gsrc),"s"(lds_dst):"memory");}
__device__ __forceinline__ float max3f(float a,float b,float c){float r;asm("v_max3_f32 %0, %1, %2, %3":"=v"(r):"v"(a),"v"(b),"v"(c));return r;}
__device__ __forceinline__ float max2f(float a,float b){float r;asm("v_max_f32_e32 %0, %1, %2":"=v"(r):"v"(a),"v"(b));return r;}
__device__ __forceinline__ float fadd_s(float a,float b){float r;asm("v_add_f32_e32 %0, %1, %2":"=v"(r):"v"(a),"v"(b));return r;}
__device__ __forceinline__ float fsub_s(float a,float b){float r;asm("v_sub_f32_e32 %0, %1, %2":"=v"(r):"v"(a),"v"(b));return r;}
typedef float f32x2_t __attribute__((ext_vector_type(2))); typedef __bf16 bf16x2_t __attribute__((ext_vector_type(2)));
__device__ __forceinline__ unsigned cvtpk_s(float lo,float hi){f32x2_t v={lo,hi};bf16x2_t b=__builtin_convertvector(v,bf16x2_t);return __builtin_bit_cast(unsigned,b);}
#define WAIT_BAR(N) asm volatile("s_waitcnt vmcnt(" #N ") lgkmcnt(0)\n\ts_barrier":::"memory")

__device__ __forceinline__ void qkt(f32x16&p0,f32x16&p1,const char*Kslot,const bf16x8*qr,const f32x16&negm,int r32,int hi){
  const char*kb=Kslot+hi*1024+r32*16;
  #pragma unroll
  for(int d0=0;d0<4;++d0){
    const bf16x8 b0=*reinterpret_cast<const bf16x8*>(kb+d0*2048);
    const bf16x8 b1=*reinterpret_cast<const bf16x8*>(kb+d0*2048+512);
    if(d0==0){p0=__builtin_amdgcn_mfma_f32_32x32x16_bf16(b0,qr[0],negm,0,0,0);p1=__builtin_amdgcn_mfma_f32_32x32x16_bf16(b1,qr[0],negm,0,0,0);}
    else{p0=__builtin_amdgcn_mfma_f32_32x32x16_bf16(b0,qr[d0],p0,0,0,0);p1=__builtin_amdgcn_mfma_f32_32x32x16_bf16(b1,qr[d0],p1,0,0,0);}}
}
typedef __attribute__((address_space(3))) const char* lds_cptr;
typedef short v4i16_t __attribute__((ext_vector_type(4)));
__device__ __forceinline__ void kload8(bf16x8*kf,lds_cptr kp){
  kf[0]=*(const __attribute__((address_space(3))) bf16x8*)(kp);      kf[1]=*(const __attribute__((address_space(3))) bf16x8*)(kp+512);
  kf[2]=*(const __attribute__((address_space(3))) bf16x8*)(kp+2048); kf[3]=*(const __attribute__((address_space(3))) bf16x8*)(kp+2560);
  kf[4]=*(const __attribute__((address_space(3))) bf16x8*)(kp+4096); kf[5]=*(const __attribute__((address_space(3))) bf16x8*)(kp+4608);
  kf[6]=*(const __attribute__((address_space(3))) bf16x8*)(kp+6144); kf[7]=*(const __attribute__((address_space(3))) bf16x8*)(kp+6656);
}
__device__ __forceinline__ void kload2(bf16x8*kf,lds_cptr kp,int j){ kf[2*j]=*(const __attribute__((address_space(3))) bf16x8*)(kp+j*2048); kf[2*j+1]=*(const __attribute__((address_space(3))) bf16x8*)(kp+j*2048+512); }
__device__ __forceinline__ s16x4 vtr(lds_cptr p){ return __builtin_bit_cast(s16x4,__builtin_amdgcn_ds_read_tr16_b64_v4i16((__attribute__((address_space(3))) v4i16_t*)p)); }
__device__ __forceinline__ float rowmax(const f32x16&p0,const f32x16&p1){
  float a=max3f(p0[0],p0[1],p1[0]),b=max3f(p0[2],p0[3],p1[1]);a=max3f(a,p1[2],p1[3]);
  #pragma unroll
  for(int r=4;r<16;r+=4){a=max3f(a,p0[r],p0[r+1]);b=max3f(b,p0[r+2],p0[r+3]);a=max3f(a,p1[r],p1[r+1]);b=max3f(b,p1[r+2],p1[r+3]);}
  const float m=max2f(a,b);
  auto rr=__builtin_amdgcn_permlane32_swap(__float_as_uint(m),__float_as_uint(m),false,false);
  return max2f(__uint_as_float(rr[0]),__uint_as_float(rr[1]));
}
__device__ __forceinline__ void pv(f32x16*o,int vb,bf16x8 pa0,bf16x8 pa1,bf16x8 pa2,bf16x8 pa3){
  #pragma unroll
  for(int d0=0;d0<2;++d0){s16x4 lo[4],hi[4];
    #pragma unroll
    for(int ks=0;ks<4;++ks){
      asm volatile("ds_read_b64_tr_b16 %0,%1 offset:%c2":"=&v"(lo[ks]):"v"(vb),"i"(d0*4096+ks*1024):"memory");
      asm volatile("ds_read_b64_tr_b16 %0,%1 offset:%c2":"=&v"(hi[ks]):"v"(vb),"i"(d0*4096+ks*1024+512):"memory");}
    asm volatile("s_waitcnt lgkmcnt(0)":::"memory");SBAR();
    #define PK(k) (bf16x8){lo[k][0],lo[k][1],lo[k][2],lo[k][3],hi[k][0],hi[k][1],hi[k][2],hi[k][3]}
    o[d0]=__builtin_amdgcn_mfma_f32_32x32x16_bf16(pa0,PK(0),o[d0],0,0,0);
    o[d0]=__builtin_amdgcn_mfma_f32_32x32x16_bf16(pa1,PK(1),o[d0],0,0,0);
    o[d0]=__builtin_amdgcn_mfma_f32_32x32x16_bf16(pa2,PK(2),o[d0],0,0,0);
    o[d0]=__builtin_amdgcn_mfma_f32_32x32x16_bf16(pa3,PK(3),o[d0],0,0,0);
    #undef PK
  }
}

#ifndef ATTN_STORE16
#define ATTN_STORE16(p,v) (*(u32x4*)(p)=(v))
#endif
template<int THRL> __device__ __forceinline__ void attn_unit(int b,int vh,int qb,const bf16*__restrict__ QKV,bf16*O,char*shm,lds_fptr tab,float b31){
  const int tid=threadIdx.x,lane=tid&63,r32=lane&31,hi=lane>>5; const int wid=__builtin_amdgcn_readfirstlane(tid>>6);
  const long rowbase=(long)b*SEQ; const int q0=qb*QB;
  const int hh=vh>>2,mm=(vh>>1)&1,vhalf=vh&1;
  const bf16*Qw=QKV+(rowbase+q0+wid*QBLK)*PQ+hh*128+mm*64;
  const bf16*Kh=QKV+rowbase*PQ+512+hh*128+mm*64,*Vh=QKV+rowbase*PQ+1024+hh*128+vhalf*64;
  const unsigned lds0=(unsigned)(uintptr_t)shm;
  float*wsf=(float*)(shm+LDS_WS)+wid*64;
  const bf16*ksrc=Kh+(long)lane*PQ+wid*8;
  const bf16*vsrc=Vh+(long)(16*(wid&3)+(lane>>2))*PQ+(wid>>2)*32+(lane&3)*8;
  const unsigned kdst=lds0+LDS_K+wid*1024, vdst=lds0+LDS_V+wid*1024;
  #define DMA_K(t,slot) glds16(ksrc+(long)(t)*KVBLK*PQ,(unsigned)__builtin_amdgcn_readfirstlane(kdst+(slot)))
  #define DMA_V(t,slot) glds16(vsrc+(long)(t)*KVBLK*PQ,(unsigned)__builtin_amdgcn_readfirstlane(vdst+(slot)))
  const int vb0=(int)(lds0+LDS_V)+((lane>>4)&1)*32+(lane&3)*8+(4*hi+((lane&15)>>2))*64;
  const char*Kbase=shm+LDS_K; bf16x8 kf[8];
  const lds_cptr shm3=(lds_cptr)shm; const lds_cptr kp0=shm3+LDS_K+hi*1024+r32*16; const lds_cptr vp0=shm3+LDS_V+((lane>>4)&1)*32+(lane&3)*8+(4*hi+((lane&15)>>2))*64;
  const int NT=(q0+QB)/KVBLK;
  DMA_K(0,0);DMA_V(0,0);DMA_K(1,SLOTB);
  bf16x8 qr[4];
  #pragma unroll
  for(int d0=0;d0<4;++d0)qr[d0]=*reinterpret_cast<const bf16x8*>(&Qw[(long)r32*PQ+d0*16+hi*8]);
  float mhat=0.f,l_reg=0.f;f32x16 o[2];o[0]=f32x16{};o[1]=f32x16{};f32x16 negm;
  #pragma unroll
  for(int r=0;r<16;++r)negm[r]=b31;
  asm volatile("":"+v"(negm));
  const int qrel=wid*QBLK+r32;
  #define CMASK(P0,P1,t) do{int dt_=(NT-4)-(t); if(dt_<=2)cmask(P0,P1,dt_,qrel,hi,tab);}while(0)
  bool resc=false;
  #define START(P0,P1) do{ const float rm=rowmax(P0,P1); resc=false; \
    { const float dl=rm; mhat=fadd_s(mhat,dl); \
      _Pragma("unroll") for(int r=0;r<16;++r){P0[r]=fsub_s(P0[r],dl);P1[r]=fsub_s(P1[r],dl);} \
      _Pragma("unroll") for(int r=0;r<16;++r)negm[r]=b31-mhat; asm volatile("":"+v"(negm)); } \
    _Pragma("unroll") for(int r=0;r<16;++r)P0[r]=__builtin_amdgcn_exp2f(P0[r]); }while(0)
  #define RESC() do{ if(resc){ asm volatile("s_waitcnt lgkmcnt(0)":::"memory"); \
      _Pragma("unroll") for(int d_=0;d_<2;++d_) _Pragma("unroll") for(int r=0;r<16;++r)o[d_][r]*=wsf[crow(r,hi)]; } }while(0)
  f32x16 pA0,pA1,pB0,pB1;
  int sl_prev=0,sl_cur=0,sl_next=SLOTB;
  #define ROT() do{sl_prev=sl_cur;sl_cur=sl_next;sl_next=(sl_next==(NSLOT-1)*SLOTB)?0:sl_next+SLOTB;}while(0)
  DMA_K(2,2*SLOTB);
  WAIT_BAR(3);
  qkt(pA0,pA1,Kbase,qr,negm,r32,hi);asm volatile("s_nop 15\n\ts_nop 7":"+v"(pA0),"+v"(pA1));CMASK(pA0,pA1,0);
  START(pA0,pA1);
  _Pragma("unroll") for(int r=0;r<16;++r)pA1[r]=__builtin_amdgcn_exp2f(pA1[r]);
  WAIT_BAR(0);
  DMA_K(3,0);DMA_V(1,SLOTB);
  ROT();
  kload8(kf,kp0+sl_cur);
  WAIT_BAR(2);
  s16x4 vlo[8],vhi[8]; u32x4 pw0,pw1,pw2,pw3;
  #define PKW(P,B) cvtpk_s(P[B],P[B+1])
  #define PAF(k) __builtin_bit_cast(bf16x8,pw##k)
  #define VFR(i) (bf16x8){vlo[i][0],vlo[i][1],vlo[i][2],vlo[i][3],vhi[i][0],vhi[i][1],vhi[i][2],vhi[i][3]}
  #define PIN(x) asm volatile("":"+v"(x))
  #define MX3(a,b,c) __builtin_fmaxf(__builtin_fmaxf((a),(b)),(c))
  #define GAPA(MF,A0,A1,A2,A3,W0,W1,PW) do{ MF; sacc+=A0; sacc+=A1; sacc+=A2; sacc+=A3; PIN(sacc); W0; W1; PIN(PW); SBAR(); }while(0)
  #define EX(v) __builtin_amdgcn_exp2f(v)
  #define GAPB(MF,X,B) do{ MF; X[B]=EX(X[B]); X[B+1]=EX(X[B+1]); X[B+2]=EX(X[B+2]); X[B+3]=EX(X[B+3]); PIN(X); SBAR(); }while(0)
  #define VRD(i) do{ vlo[i]=vtr(vp_+(((i)>>2)*4096+((i)&3)*1024)); vhi[i]=vtr(vp_+(((i)>>2)*4096+((i)&3)*1024+512)); }while(0)
  #define KRD(G,j) do{ if(G){ kload2(kf,kp0+sl_next,j); SBAR(); } }while(0)
  #define STEP(C0,C1,P0,P1,t,GK,GV,GL) do{ SBAR(); \
    const lds_cptr vp_=vp0+sl_prev; \
    VRD(0); SBAR(); float sacc=(P0[0]+P0[1]); \
    GAPA(C0=__builtin_amdgcn_mfma_f32_32x32x16_bf16(kf[0],qr[0],negm,0,0,0), P0[2],P0[3],P0[4],P0[5],     pw0[0]=PKW(P0,0), pw0[1]=PKW(P0,2), pw0); \
    VRD(4); SBAR(); GAPA(C1=__builtin_amdgcn_mfma_f32_32x32x16_bf16(kf[1],qr[0],negm,0,0,0), P0[6],P0[7],P0[8],P0[9],     pw0[2]=PKW(P0,4), pw0[3]=PKW(P0,6), pw0); \
    VRD(1); SBAR(); GAPA(C0=__builtin_amdgcn_mfma_f32_32x32x16_bf16(kf[2],qr[1],C0,0,0,0),   P0[10],P0[11],P0[12],P0[13], pw1[0]=PKW(P0,8), pw1[1]=PKW(P0,10), pw1); \
    VRD(5); SBAR(); GAPA(C1=__builtin_amdgcn_mfma_f32_32x32x16_bf16(kf[3],qr[1],C1,0,0,0),   P0[14],P0[15],P1[0],P1[1],   pw1[2]=PKW(P0,12),pw1[3]=PKW(P0,14), pw1); \
    VRD(2); SBAR(); GAPA(C0=__builtin_amdgcn_mfma_f32_32x32x16_bf16(kf[4],qr[2],C0,0,0,0),   P1[2],P1[3],P1[4],P1[5],     pw2[0]=PKW(P1,0), pw2[1]=PKW(P1,2), pw2); \
    VRD(6); SBAR(); GAPA(C1=__builtin_amdgcn_mfma_f32_32x32x16_bf16(kf[5],qr[2],C1,0,0,0),   P1[6],P1[7],P1[8],P1[9],     pw2[2]=PKW(P1,4), pw2[3]=PKW(P1,6), pw2); \
    VRD(3); SBAR(); GAPA(C0=__builtin_amdgcn_mfma_f32_32x32x16_bf16(kf[6],qr[3],C0,0,0,0),   P1[10],P1[11],P1[12],P1[13], pw3[0]=PKW(P1,8), pw3[1]=PKW(P1,10), pw3); \
    VRD(7); SBAR(); GAPA(C1=__builtin_amdgcn_mfma_f32_32x32x16_bf16(kf[7],qr[3],C1,0,0,0),   P1[14],P1[15],0.f,0.f,       pw3[2]=PKW(P1,12),pw3[3]=PKW(P1,14), pw3); \
    l_reg+=sacc; \
    if(GK){DMA_K((t)+3,sl_cur);} if(GV){DMA_V((t)+1,sl_next);} \
    CMASK(C0,C1,t); \
    { float a=MX3(C0[0],C0[1],C1[0]),b=MX3(C0[2],C0[3],C1[1]); a=MX3(a,C1[2],C1[3]); \
      _Pragma("unroll") for(int r=4;r<16;r+=4){a=MX3(a,C0[r],C0[r+1]);b=MX3(b,C0[r+2],C0[r+3]);a=MX3(a,C1[r],C1[r+1]);b=MX3(b,C1[r+2],C1[r+3]);} \
      float rm=__builtin_fmaxf(a,b); { auto rr=__builtin_amdgcn_permlane32_swap(__float_as_uint(rm),__float_as_uint(rm),false,false); rm=__builtin_fmaxf(__uint_as_float(rr[0]),__uint_as_float(rr[1])); } \
      resc=false; \
      if(__builtin_expect(__any(rm>(float)THRL),0)){ const float dl=__builtin_fmaxf(rm,0.f); mhat+=dl; \
        _Pragma("unroll") for(int r=0;r<16;++r){C0[r]-=dl;C1[r]-=dl;} \
        _Pragma("unroll") for(int r=0;r<16;++r)negm[r]=b31-mhat; asm volatile("":"+v"(negm)); \
        const float f=__builtin_amdgcn_exp2f(-dl); l_reg*=f; if(hi==0)wsf[r32]=f; resc=true; } } \
    SBAR(); \
    GAPB(o[0]=__builtin_amdgcn_mfma_f32_32x32x16_bf16(PAF(0),VFR(0),o[0],0,0,0), C0,0); \
    GAPB(o[1]=__builtin_amdgcn_mfma_f32_32x32x16_bf16(PAF(0),VFR(4),o[1],0,0,0), C0,4); \
    KRD(GL,0); GAPB(o[0]=__builtin_amdgcn_mfma_f32_32x32x16_bf16(PAF(1),VFR(1),o[0],0,0,0), C0,8); \
    KRD(GL,1); GAPB(o[1]=__builtin_amdgcn_mfma_f32_32x32x16_bf16(PAF(1),VFR(5),o[1],0,0,0), C0,12); \
    KRD(GL,2); GAPB(o[0]=__builtin_amdgcn_mfma_f32_32x32x16_bf16(PAF(2),VFR(2),o[0],0,0,0), C1,0); \
    KRD(GL,3); GAPB(o[1]=__builtin_amdgcn_mfma_f32_32x32x16_bf16(PAF(2),VFR(6),o[1],0,0,0), C1,4); \
    GAPB(o[0]=__builtin_amdgcn_mfma_f32_32x32x16_bf16(PAF(3),VFR(3),o[0],0,0,0), C1,8); \
    GAPB(o[1]=__builtin_amdgcn_mfma_f32_32x32x16_bf16(PAF(3),VFR(7),o[1],0,0,0), C1,12); \
    }while(0)
  int t=1;
  #undef CMASK
  #define CMASK(P0,P1,t) do{}while(0)
  for(;t+7<NT;t+=2){
    STEP(pB0,pB1,pA0,pA1,t,true,true,true);     WAIT_BAR(2); RESC(); ROT();
    STEP(pA0,pA1,pB0,pB1,t+1,true,true,true);   WAIT_BAR(2); RESC(); ROT();
  }
  #undef CMASK
  #define CMASK(P0,P1,t) do{int dt_=(NT-4)-(t); if(dt_<=2)cmask(P0,P1,dt_,qrel,hi,tab);}while(0)
  #define ENDW(tt) do{ if((tt)+3<NT){WAIT_BAR(2);} else if((tt)+2<NT){WAIT_BAR(1);} else {WAIT_BAR(0);} }while(0)
  for(;t+1<NT;t+=2){
    STEP(pB0,pB1,pA0,pA1,t,(t+3<NT),(t+1<NT),(t+1<NT));       ENDW(t);   RESC(); ROT();
    STEP(pA0,pA1,pB0,pB1,t+1,(t+4<NT),(t+2<NT),(t+2<NT));     ENDW(t+1); RESC(); ROT();
  }
  STEP(pB0,pB1,pA0,pA1,NT-1,false,false,false); RESC();
  { float sacc=pB0[0]+pB0[1]; _Pragma("unroll") for(int r=2;r<16;++r)sacc+=pB0[r]; _Pragma("unroll") for(int r=0;r<16;++r)sacc+=pB1[r]; l_reg+=sacc;
    pw0=(u32x4){PKW(pB0,0),PKW(pB0,2),PKW(pB0,4),PKW(pB0,6)};pw1=(u32x4){PKW(pB0,8),PKW(pB0,10),PKW(pB0,12),PKW(pB0,14)};pw2=(u32x4){PKW(pB1,0),PKW(pB1,2),PKW(pB1,4),PKW(pB1,6)};pw3=(u32x4){PKW(pB1,8),PKW(pB1,10),PKW(pB1,12),PKW(pB1,14)};
    SBAR(); pv(o,vb0+sl_cur,PAF(0),PAF(1),PAF(2),PAF(3)); }
  #undef PKW
  #undef PAF
  #undef VFR
  #undef PIN
  #undef MX3
  #undef GAPA
  #undef GAPB
  #undef EX
  #undef VRD
  #undef KRD
  #undef STEP
  #undef ENDW
  {auto rr=__builtin_amdgcn_permlane32_swap(__float_as_uint(l_reg),__float_as_uint(l_reg),false,false);l_reg=__uint_as_float(rr[0])+__uint_as_float(rr[1]);}
  if(hi==0)wsf[32+r32]=l_reg;asm volatile("s_waitcnt lgkmcnt(0)":::"memory");
  float rli[16];
  #pragma unroll
  for(int r=0;r<16;++r)rli[r]=__builtin_amdgcn_rcpf(wsf[32+crow(r,hi)]);
  bf16*Ow=O+(rowbase+q0+wid*QBLK)*DM+vh*D;
  { bf16*stg=(bf16*)(shm+LDS_OST)+wid*2048;
    #pragma unroll
    for(int r=0;r<16;++r){const int orow=crow(r,hi);
      #pragma unroll
      for(int d0=0;d0<2;++d0)stg[orow*64+d0*32+r32]=__float2bfloat16(o[d0][r]*rli[r]);}
    asm volatile("s_waitcnt lgkmcnt(0)":::"memory");
    #pragma unroll
    for(int i=0;i<4;++i){const int row=i*8+(lane>>3),ch=lane&7; const u32x4 v=*(const u32x4*)(stg+row*64+ch*8); ATTN_STORE16(Ow+(long)row*DM+ch*8,v);} }
  asm volatile("s_waitcnt lgkmcnt(0)\n\ts_barrier":::"memory");
  #undef DMA_K
  #undef DMA_V
  #undef CMASK
  #undef START
  #undef RESC
  #undef ROT
}
constexpr int ATTN_LDS_BYTES=LDS_BYTES;
struct AttnTensors { const bf16* QKV; bf16* O; lds_fptr tabs; lds_fptr b31; };
struct AttnUnit { int bh; int qb; };
struct StaticOrder {
  int vcu,G;
  __device__ __forceinline__ StaticOrder(int grid,int v):vcu(v),G(grid){}
  __device__ __forceinline__ bool next(int i,AttnUnit&u)const{ const int pr=vcu+(i>>4)*G; if(pr>=BATCH*NHEAD)return false; u.bh=pr; u.qb=15-(i&15); return true; }
};
template<class Sched,int THRL=8> __device__ __forceinline__ void attn_phase(char*lds,const AttnTensors&T,const Sched&S){
  AttnUnit u;
  for(int i=0;S.next(i,u);++i){ const int vh=u.bh%NHEAD; attn_unit<THRL>(u.bh/NHEAD,vh,u.qb,T.QKV,T.O,lds,T.tabs+(vh>>2)*TABN,T.b31[vh>>2]); }
}
#undef SBAR
#undef WAIT_BAR
}


constexpr int NWAVES = 8;
constexpr int BATCH = 16, SEQ = 4096, D = 1024, T = BATCH * SEQ;
constexpr int NPH = 15;
constexpr float NORM_EPS = 1e-6f, SUBLN_EPS = 1e-5f, LAMBDA_INIT = 0.2f, LOG2E = 1.4426950408889634f;

constexpr size_t MiB = 1u << 20;
constexpr size_t WS_CTL = 0, CTL_ZERO_BYTES = 2 * MiB;
constexpr size_t WS_MOD = 1 * MiB;
constexpr size_t WS_TAB = 2 * MiB;
constexpr size_t TAB_BBT = 0, TAB_CCT = 128 * 1024, TAB_A = 256 * 1024, TAB_AL = 272 * 1024, TAB_BIAS = 288 * 1024, TAB_B31 = 300 * 1024, TAB_LAM = 300 * 1024 + 64;
constexpr size_t WS_WIN = 4 * MiB, WS_WGLU = 12 * MiB, WS_WPA = 13 * MiB, WS_WPS = 14 * MiB, WS_WOUT = 15 * MiB, WS_WR = 17 * MiB, WS_WE1 = 18 * MiB, WS_WE2 = 82 * MiB;
constexpr size_t WS_QKVU = 128 * MiB, WS_GATES = 384 * MiB, WS_H1 = 640 * MiB, WS_OV = 640 * MiB, WS_TMP = 640 * MiB, WS_YATTN = 768 * MiB, WS_YSSM = 832 * MiB, WS_S = 896 * MiB,
                 WS_SSMEND = 960 * MiB, WS_MERGED = 128 * MiB, WS_X1 = 384 * MiB, WS_H2 = 896 * MiB, WS_LOGITS = 264 * MiB, WS_LIST = 280 * MiB, WS_TOK = 288 * MiB, WS_ACT = 128 * MiB, WS_YS = 640 * MiB,
                 WS_END = 1024 * MiB;
constexpr int CW_TMO = 0, CW_CODE = 1, CW_BAR = 4096, CW_CNT = 8192;

constexpr int RING_OFF = 0, RING_BYTES = 131072;
constexpr int LDSCTL_OFF = RING_BYTES, MISC_OFF = LDSCTL_OFF + 320;
constexpr int TBL_OFF = LDSCTL_OFF + 512;
constexpr int TBL_TILE_E = TBL_OFF, TBL_TSTART = TBL_OFF + 2304, TBL_CNT = TBL_TSTART + 256, TBL_ROWTAB = TBL_CNT + 128, ROWTAB_UNITS = 10;
constexpr int LDS_BYTES = 147456;
static_assert(TBL_ROWTAB + ROWTAB_UNITS * 1024 <= LDS_BYTES, "LDS map");
constexpr int ATT_TAB_OFF = 86016;

#define GAS __attribute__((address_space(1)))
#define LAS __attribute__((address_space(3)))
typedef unsigned short bf16;
typedef unsigned v4u __attribute__((ext_vector_type(4)));
typedef float f32x4 __attribute__((ext_vector_type(4)));
typedef short bf16x8 __attribute__((ext_vector_type(8)));
typedef GAS unsigned gu32;
typedef GAS unsigned long long gu64;
#define RLX_AGENT __ATOMIC_RELAXED, __HIP_MEMORY_SCOPE_AGENT
#define LDS_WAIT() asm volatile("s_waitcnt lgkmcnt(0)" ::: "memory")
#define VM_WAIT() asm volatile("s_waitcnt vmcnt(0)" ::: "memory")
__device__ __forceinline__ unsigned long long rt() { return __builtin_amdgcn_s_memrealtime(); }
__device__ __forceinline__ unsigned f2bf(float f) { unsigned u = __builtin_bit_cast(unsigned, f); return (u + 0x7fffu + ((u >> 16) & 1u)) >> 16; }
__device__ __forceinline__ unsigned pk2(float lo, float hi) { return f2bf(lo) | (f2bf(hi) << 16); }

#define XB_TMO      128
#define XB_XCNT(j)  (256  + 64 * (j))
#define XB_XSUB(j)  (1280 + 64 * (j))
#define XB_XGEN(j)  (2304 + 64 * (j))
#define XB_TOP      3328
#define XB_TOPGEN   3392
#define XCD_BAR_WORDS 3456
#define XB_SPIN_CAP (1u << 18)

__device__ __forceinline__ unsigned xb_ld(unsigned* p)              { return __hip_atomic_load(p, __ATOMIC_RELAXED, __HIP_MEMORY_SCOPE_AGENT); }
__device__ __forceinline__ unsigned xb_add(unsigned* p, unsigned v) { return __hip_atomic_fetch_add(p, v, __ATOMIC_RELAXED, __HIP_MEMORY_SCOPE_AGENT); }
__device__ __forceinline__ unsigned xb_xcc_id() { return (unsigned)__builtin_amdgcn_s_getreg((3 << 11) | 20) & 0xFu; }
#define XB_SPIN(cond, bar) do { unsigned _sp = 0; while (cond) { __builtin_amdgcn_s_sleep(1); \
    if ((++_sp & 255u) == 0u) { if (xb_ld(&(bar)[XB_TMO])) break; if (_sp > XB_SPIN_CAP) { atomicAdd(&(bar)[XB_TMO], 1u); break; } } } } while (0)

struct XcdBarrier {
    unsigned* bar; unsigned x;
    volatile LAS unsigned* st;
};

__device__ __forceinline__ XcdBarrier xcd_barrier_post(unsigned* bar, volatile LAS unsigned* st) {
    XcdBarrier b; b.bar = bar; b.x = xb_xcc_id(); b.st = st;
    if (threadIdx.x == 0) (void)xb_add(&bar[XB_XCNT(b.x)], 1u);
    return b;
}
__device__ __forceinline__ void xcd_barrier_complete(unsigned* bar, unsigned x, unsigned& nloc, unsigned& nx) {
    const unsigned G = gridDim.x * gridDim.y * gridDim.z;
    unsigned sum, cnt, mine, sp = 0u;
    for (;;) {
        sum = 0u; cnt = 0u; mine = 0u;
#pragma unroll
        for (unsigned j = 0; j < 16; ++j) { const unsigned c = xb_ld(&bar[XB_XCNT(j)]); sum += c; cnt += (c > 0u) ? 1u : 0u; mine = (j == x) ? c : mine; }
        if (sum == G) break;
        __builtin_amdgcn_s_sleep(1);
        if ((++sp & 255u) == 0u) { if (xb_ld(&bar[XB_TMO])) break; if (sp > XB_SPIN_CAP) { atomicAdd(&bar[XB_TMO], 1u); break; } }
    }
    nloc = mine > 0u ? mine : 1u; nx = cnt > 0u ? cnt : 1u;
}

__device__ __forceinline__ void xcd_barrier(const XcdBarrier& b) {
    asm volatile("s_waitcnt vmcnt(0)" ::: "memory");
    __syncthreads();
    if (threadIdx.x == 0) {
        unsigned* bar = b.bar;
        __builtin_amdgcn_s_waitcnt(0);
        unsigned nloc = b.st[0], nx = b.st[1];
        if (nloc == 0u) { xcd_barrier_complete(bar, b.x, nloc, nx); b.st[0] = nloc; b.st[1] = nx; }
        const unsigned old = xb_add(&bar[XB_XSUB(b.x)], 1u);
        const unsigned gen = old / nloc;
        if (old + 1u == (gen + 1u) * nloc) {
            __builtin_amdgcn_fence(__ATOMIC_RELEASE, "agent");
            asm volatile("s_waitcnt vmcnt(0)" ::: "memory");
            const unsigned og = xb_add(&bar[XB_TOP], 1u);
            const unsigned tg = og / nx;
            if (og + 1u == (tg + 1u) * nx) xb_add(&bar[XB_TOPGEN], 1u);
            else XB_SPIN(xb_ld(&bar[XB_TOPGEN]) == tg, bar);
            __builtin_amdgcn_fence(__ATOMIC_ACQUIRE, "agent");
            xb_add(&bar[XB_XGEN(b.x)], 1u);
            asm volatile("s_waitcnt vmcnt(0)" ::: "memory");
        } else {
            XB_SPIN(xb_ld(&bar[XB_XGEN(b.x)]) == gen, bar);
            __builtin_amdgcn_fence(__ATOMIC_ACQUIRE, "agent");
            asm volatile("s_waitcnt vmcnt(0)" ::: "memory");
        }
    }
    __syncthreads();
}


struct Frame {
    LAS unsigned char* lds;
    volatile LAS unsigned* MISC;
    gu32* ctl;
    int tid, lane, wave;
    int vcu, G;
    const float* in[32]; float* out; unsigned char* ws;
};
#define WSP(T_, off) ((T_*)(F.ws + (off)))
__device__ __forceinline__ float wave_sum(float v) {
#pragma unroll
    for (int o = 1; o < 64; o <<= 1) v += __shfl_xor(v, o);
    return v;
}
__device__ __forceinline__ float bflo(unsigned w) { return __uint_as_float(w << 16); }
__device__ __forceinline__ float bfhi(unsigned w) { return __uint_as_float(w & 0xffff0000u); }
__device__ __forceinline__ float sigm_(float x) { return __builtin_amdgcn_rcpf(1.f + __builtin_amdgcn_exp2f(-LOG2E * x)); }

__device__ __forceinline__ void p0_transpose_item(const float* W, int K, int N, bf16* WT, int permHalf, LAS float* scr, int item, int lane) {
    const int nblk = N / 32, kb = item / nblk, nb = item % nblk, k0 = 64 * kb, n0 = 32 * nb;
#pragma unroll 8
    for (int i = 0; i < 32; ++i) { const int kk = 2 * i + (lane >> 5); scr[kk * 33 + (lane & 31)] = W[(size_t)(k0 + kk) * N + n0 + (lane & 31)]; }
    LDS_WAIT(); asm volatile("" ::: "memory");
    const int c = lane & 7;
    int r0 = n0; if (permHalf) { const int bj = n0 / permHalf, idx = n0 % permHalf; r0 = 256 * (idx / 128) + 128 * bj + (idx % 128); }
#pragma unroll
    for (int j = 0; j < 4; ++j) { const int n = (lane >> 3) + 8 * j; const LAS float* s = scr + (8 * c) * 33 + n;
        v4u o; o.x = pk2(s[0 * 33], s[1 * 33]); o.y = pk2(s[2 * 33], s[3 * 33]); o.z = pk2(s[4 * 33], s[5 * 33]); o.w = pk2(s[6 * 33], s[7 * 33]);
        *(GAS v4u*)(WT + (size_t)(r0 + n) * K + k0 + 8 * c) = o; }
    LDS_WAIT(); asm volatile("" ::: "memory");
}
__device__ __forceinline__ void p0_prologue(Frame& F) {
    LAS float* scr = (LAS float*)(F.lds + RING_OFF + F.wave * 16384);
    const int gw = F.vcu * NWAVES + F.wave, NGW = F.G * NWAVES, lane = F.lane;
    constexpr int I_IN = 16 * 128, I_GLU = 8 * 32, I_PA = 8 * 32, I_PS = 8 * 32, I_OUT = 16 * 32, I_E1 = 32 * 512, I_E2 = 32 * 256, I_R = 256, I_SSM = 32, I_MISC = 1;
    constexpr int NITEMS = I_IN + I_GLU + I_PA + I_PS + I_OUT + I_E1 + I_E2 + I_R + I_SSM + I_MISC;
    for (int cb = F.vcu; cb < 96; cb += F.G) {
        const int j = cb * 64 + lane, k0 = F.wave * 128; const float* c = F.in[1]; const float* wa = F.in[2];
#pragma unroll
        for (int q = 0; q < 32; ++q) { const int idx = q * 64 + lane, kk = idx >> 4, b = idx & 15; const float v = c[b * 1024 + k0 + kk]; scr[idx] = v * sigm_(v); }
        LDS_WAIT(); asm volatile("" ::: "memory");
        float acc[16];
#pragma unroll
        for (int b = 0; b < 16; ++b) acc[b] = 0.f;
#pragma unroll 8
        for (int kk = 0; kk < 128; ++kk) { const float w = wa[(size_t)(k0 + kk) * 6144 + j];
#pragma unroll
            for (int q = 0; q < 4; ++q) { const f32x4 cv = *(const LAS f32x4*)(scr + kk * 16 + 4 * q); acc[4 * q] += w * cv.x; acc[4 * q + 1] += w * cv.y; acc[4 * q + 2] += w * cv.z; acc[4 * q + 3] += w * cv.w; } }
#pragma unroll
        for (int b = 0; b < 16; ++b) scr[2048 + b * 64 + lane] = acc[b];
        __syncthreads();
        float* mod = WSP(float, WS_MOD);
#pragma unroll
        for (int bb = 0; bb < 2; ++bb) { const int b = F.wave + 8 * bb; float sum = F.in[3][j];
#pragma unroll
            for (int w2 = 0; w2 < 8; ++w2) sum += ((const LAS float*)(F.lds + RING_OFF + w2 * 16384))[2048 + b * 64 + lane];
            mod[b * 6144 + j] = sum; }
        __syncthreads();
    }
    for (int it = gw; it < NITEMS; it += NGW) {
        int r = it;
        if (r < I_IN) { p0_transpose_item(F.in[5], 1024, 4096, WSP(bf16, WS_WIN), 0, scr, r, lane); continue; } r -= I_IN;
        if (r < I_GLU) { p0_transpose_item(F.in[20], 512, 1024, WSP(bf16, WS_WGLU), 512, scr, r, lane); continue; } r -= I_GLU;
        if (r < I_PA) { p0_transpose_item(F.in[21], 512, 1024, WSP(bf16, WS_WPA), 0, scr, r, lane); continue; } r -= I_PA;
        if (r < I_PS) { p0_transpose_item(F.in[22], 512, 1024, WSP(bf16, WS_WPS), 0, scr, r, lane); continue; } r -= I_PS;
        if (r < I_OUT) { p0_transpose_item(F.in[23], 1024, 1024, WSP(bf16, WS_WOUT), 0, scr, r, lane); continue; } r -= I_OUT;
        if (r < I_E1) { const int e = r / 512; p0_transpose_item(F.in[29] + (size_t)e * 1024 * 1024, 1024, 1024, WSP(bf16, WS_WE1) + (size_t)e * 1024 * 1024, 512, scr, r % 512, lane); continue; } r -= I_E1;
        if (r < I_E2) { const int e = r / 256; p0_transpose_item(F.in[30] + (size_t)e * 512 * 1024, 512, 1024, WSP(bf16, WS_WE2) + (size_t)e * 1024 * 512, 0, scr, r % 256, lane); continue; } r -= I_E2;
        if (r < I_R) {
            const int n = r; bf16* dst = WSP(bf16, WS_WR) + (size_t)n * 1024;
            for (int k = lane; k < 1024; k += 64) { float v = 0.f;
                if (n < 4) v = F.in[25][k * 4 + n]; else if (n < 36) { const int gq = (n - 4) >> 3, e = (n - 4) & 7; v = F.in[27][((size_t)gq * 1024 + k) * 8 + e]; }
                dst[k] = (bf16)f2bf(v); }
            continue; } r -= I_R;
        if (r < I_SSM) {
            const int g = r, p = lane;
            const float lr = fminf(F.in[12][g * 64 + p], -1e-4f), li = F.in[13][g * 64 + p], step = expf(F.in[14][g]);
            const float mag = expf(lr * step), ang = li * step, a_re = mag * cosf(ang), a_im = mag * sinf(ang);
            const float den = lr * lr + li * li, num_re = a_re - 1.0f, coef_re = (num_re * lr + a_im * li) / den, coef_im = (a_im * lr - num_re * li) / den;
            float* At = WSP(float, WS_TAB + TAB_A); float* AL = WSP(float, WS_TAB + TAB_AL);
            At[(g * 64 + p) * 2] = a_re; At[(g * 64 + p) * 2 + 1] = a_im;
            float zr = a_re, zi = a_im;
#pragma unroll
            for (int s = 0; s < 8; ++s) { const float nr = zr * zr - zi * zi, ni = 2.f * zr * zi; zr = nr; zi = ni; }
            AL[(g * 64 + p) * 2] = zr; AL[(g * 64 + p) * 2 + 1] = zi;
            bf16* BBt = WSP(bf16, WS_TAB + TAB_BBT); bf16* CCt = WSP(bf16, WS_TAB + TAB_CCT);
            const int n_re = ((p < 32) ? 0 : 64) + (p & 31), n_im = n_re + 32;
            for (int h = 0; h < 16; ++h) { const float br = F.in[15][(g * 64 + p) * 16 + h], bi = F.in[16][(g * 64 + p) * 16 + h];
                BBt[(g * 128 + n_re) * 16 + h] = (bf16)f2bf(coef_re * br - coef_im * bi); BBt[(g * 128 + n_im) * 16 + h] = (bf16)f2bf(coef_re * bi + coef_im * br);
                CCt[(g * 16 + h) * 128 + 2 * p] = (bf16)f2bf(F.in[17][(g * 16 + h) * 64 + p]); CCt[(g * 16 + h) * 128 + 2 * p + 1] = (bf16)f2bf(-F.in[18][(g * 16 + h) * 64 + p]); }
            continue; } r -= I_SSM;
        {
            float* tb = WSP(float, WS_TAB + TAB_BIAS); float* b31 = WSP(float, WS_TAB + TAB_B31); float* lamp = WSP(float, WS_TAB + TAB_LAM);
            const float* rb = F.in[6];
            for (int idx = lane; idx < 4 * attn_body::TABN; idx += 64) { const int h = idx / attn_body::TABN, d = idx % attn_body::TABN - 255; float v = 0.f;
                if (d < 0) v = -INFINITY;
                else if (d < 128) { int bk;
                    if (d < 16) bk = d; else { const float lr = logf((float)d / 16.f) / logf(8.f); bk = 16 + (int)(lr * 16.f); bk = bk > 31 ? 31 : bk; }
                    v = (rb[bk * 4 + h] - rb[31 * 4 + h]) * LOG2E; }
                tb[idx] = v; }
            if (lane < 4) b31[lane] = rb[31 * 4 + lane] * LOG2E;
            const float s1 = wave_sum(F.in[7][lane] * F.in[8][lane]), s2 = wave_sum(F.in[9][lane] * F.in[10][lane]);
            if (lane == 0) lamp[0] = expf(s1) - expf(s2) + LAMBDA_INIT;
        }
    }
}

__device__ __forceinline__ void ln_mod_row(int lane, const float* xrow, const float* gv, const float* shift, const float* scale, bf16* orow) {
    const GAS f32x4* xr = (const GAS f32x4*)xrow + lane;
    f32x4 v[4]; float s = 0.f;
#pragma unroll
    for (int j = 0; j < 4; ++j) { v[j] = xr[64 * j]; s += (v[j].x * v[j].x + v[j].y * v[j].y) + (v[j].z * v[j].z + v[j].w * v[j].w); }
    const float rstd = 1.f / sqrtf(wave_sum(s) * (1.f / D) + NORM_EPS);
    GAS unsigned long long* o8 = (GAS unsigned long long*)orow + lane;
#pragma unroll
    for (int j = 0; j < 4; ++j) { const f32x4 g4 = ((const f32x4*)gv)[lane + 64 * j], sh = ((const f32x4*)shift)[lane + 64 * j], sc = ((const f32x4*)scale)[lane + 64 * j];
        const f32x4 h = v[j] * rstd * g4 * (sc + 1.f) + sh;
        o8[64 * j] = (unsigned long long)pk2(h.x, h.y) | ((unsigned long long)pk2(h.z, h.w) << 32); }
}
__device__ __forceinline__ void ln_phase(Frame& F, const float* x, const float* gv, int shift_off, int scale_off, bf16* out) {
    const int gw = F.vcu * NWAVES + F.wave, NGW = F.G * NWAVES; const float* mod = WSP(float, WS_MOD);
    for (int m = gw; m < T; m += NGW) { const float* mb = mod + (size_t)(m >> 12) * 6144; ln_mod_row(F.lane, x + (size_t)m * D, gv, mb + shift_off, mb + scale_off, out + (size_t)m * D); }
}
__device__ __forceinline__ void attn_combine_phase(Frame& F) {
    const int gw = F.vcu * NWAVES + F.wave, NGW = F.G * NWAVES, lane = F.lane;
    const bf16* Ov = WSP(bf16, WS_OV); bf16* ya = WSP(bf16, WS_YATTN);
    const float lam = WSP(float, WS_TAB + TAB_LAM)[0];
    const int h = lane >> 4, half = (lane >> 3) & 1, d0 = 8 * (lane & 7);
    float gsub[8];
#pragma unroll
    for (int i = 0; i < 8; ++i) gsub[i] = F.in[11][half * 64 + d0 + i] * (1.f - LAMBDA_INIT);
    for (int m = gw; m < T; m += NGW) {
        const v4u a = *(const GAS v4u*)(Ov + (size_t)m * 1024 + (h * 4 + half) * 64 + d0), b = *(const GAS v4u*)(Ov + (size_t)m * 1024 + (h * 4 + 2 + half) * 64 + d0);
        float o[8];
        o[0] = bflo(a.x) - lam * bflo(b.x); o[1] = bfhi(a.x) - lam * bfhi(b.x); o[2] = bflo(a.y) - lam * bflo(b.y); o[3] = bfhi(a.y) - lam * bfhi(b.y);
        o[4] = bflo(a.z) - lam * bflo(b.z); o[5] = bfhi(a.z) - lam * bfhi(b.z); o[6] = bflo(a.w) - lam * bflo(b.w); o[7] = bfhi(a.w) - lam * bfhi(b.w);
        float ss = 0.f;
#pragma unroll
        for (int i = 0; i < 8; ++i) ss += o[i] * o[i];
        ss += __shfl_xor(ss, 1); ss += __shfl_xor(ss, 2); ss += __shfl_xor(ss, 4); ss += __shfl_xor(ss, 8);
        const float rs = 1.f / sqrtf(ss * (1.f / 128.f) + SUBLN_EPS);
        v4u w; w.x = pk2(o[0] * rs * gsub[0], o[1] * rs * gsub[1]); w.y = pk2(o[2] * rs * gsub[2], o[3] * rs * gsub[3]); w.z = pk2(o[4] * rs * gsub[4], o[5] * rs * gsub[5]); w.w = pk2(o[6] * rs * gsub[6], o[7] * rs * gsub[7]);
        *(GAS v4u*)(ya + (size_t)m * 512 + h * 128 + half * 64 + d0) = w;
    }
}

typedef float f32x16 __attribute__((ext_vector_type(16)));
template <int PASS> __device__ __forceinline__ void ssm_phase(Frame& F) {
    const int lane = F.lane, w = F.wave, q = lane & 31, hf = lane >> 5;
    LAS unsigned char* xl = F.lds + RING_OFF + w * 8704;
    const bf16* QKVU = WSP(bf16, WS_QKVU); bf16* YS = WSP(bf16, WS_YSSM); float* endp = WSP(float, WS_SSMEND);
    const bf16* BBt = WSP(bf16, WS_TAB + TAB_BBT); const bf16* CCt = WSP(bf16, WS_TAB + TAB_CCT); const float* At = WSP(float, WS_TAB + TAB_A); const float* AL = WSP(float, WS_TAB + TAB_AL);
    for (int unit = F.vcu; unit < 512; unit += F.G) {
        const int b = unit >> 5, cp = (unit >> 2) & 7, go = unit & 3, g = go * 8 + w, cc = cp + 8 * hf;
        bf16x8 Bf[4];
#pragma unroll
        for (int j = 0; j < 4; ++j) Bf[j] = *(const GAS bf16x8*)(BBt + (size_t)(g * 128 + j * 32 + q) * 16 + 8 * hf);
        const float ar0 = At[(g * 64 + q) * 2], ai0 = At[(g * 64 + q) * 2 + 1], ar1 = At[(g * 64 + 32 + q) * 2], ai1 = At[(g * 64 + 32 + q) * 2 + 1];
        float xr0 = 0.f, xi0 = 0.f, xr1 = 0.f, xi1 = 0.f;
        bf16x8 Cf[4]; float dsk[4];
        if (PASS == 2) {
            const float lr0 = AL[(g * 64 + q) * 2], li0 = AL[(g * 64 + q) * 2 + 1], lr1 = AL[(g * 64 + 32 + q) * 2], li1 = AL[(g * 64 + 32 + q) * 2 + 1];
            const float* eb = endp + (size_t)((b * 32 + g) * 16) * 128;
            for (int j = 0; j < 15; ++j) if (j < cc) {
                const float e0r = eb[j * 128 + q * 2], e0i = eb[j * 128 + q * 2 + 1], e1r = eb[j * 128 + (q + 32) * 2], e1i = eb[j * 128 + (q + 32) * 2 + 1];
                const float n0r = lr0 * xr0 - li0 * xi0 + e0r, n0i = lr0 * xi0 + li0 * xr0 + e0i, n1r = lr1 * xr1 - li1 * xi1 + e1r, n1i = lr1 * xi1 + li1 * xr1 + e1i;
                xr0 = n0r; xi0 = n0i; xr1 = n1r; xi1 = n1i; }
#pragma unroll
            for (int kk = 0; kk < 4; ++kk) Cf[kk] = *(const GAS bf16x8*)(CCt + (size_t)(g * 16 + (lane & 15)) * 128 + 32 * kk + 8 * (lane >> 4));
#pragma unroll
            for (int i = 0; i < 4; ++i) dsk[i] = F.in[19][g * 16 + 4 * (lane >> 4) + i];
        }
        const int cs = (q >> 2) & 1, lt = (q >> 3) * 4 + (q & 3);
        const bf16* up = QKVU + ((size_t)b * SEQ + (cp + 8 * cs) * 256 + lt) * 2048 + 1536 + g * 16 + 8 * hf;
        bf16x8 Af = *(const GAS bf16x8*)up;
        for (int sb = 0; sb < 16; ++sb) {
            bf16x8 An = Af; if (sb < 15) An = *(const GAS bf16x8*)(up + (size_t)(sb + 1) * 16 * 2048);
            f32x16 z;
#pragma unroll
            for (int i = 0; i < 16; ++i) z[i] = 0.f;
            const f32x16 c0 = __builtin_amdgcn_mfma_f32_32x32x16_bf16(Af, Bf[0], z, 0, 0, 0), c1 = __builtin_amdgcn_mfma_f32_32x32x16_bf16(Af, Bf[1], z, 0, 0, 0),
                         c2 = __builtin_amdgcn_mfma_f32_32x32x16_bf16(Af, Bf[2], z, 0, 0, 0), c3 = __builtin_amdgcn_mfma_f32_32x32x16_bf16(Af, Bf[3], z, 0, 0, 0);
#pragma unroll
            for (int i = 0; i < 16; ++i) {
                const float n0r = fmaf(-ai0, xi0, fmaf(ar0, xr0, c0[i])), n0i = fmaf(ai0, xr0, fmaf(ar0, xi0, c1[i]));
                const float n1r = fmaf(-ai1, xi1, fmaf(ar1, xr1, c2[i])), n1i = fmaf(ai1, xr1, fmaf(ar1, xi1, c3[i]));
                xr0 = n0r; xi0 = n0i; xr1 = n1r; xi1 = n1i;
                if (PASS == 2) { LAS unsigned* dst = (LAS unsigned*)(xl + (16 * hf + i) * 272 + q * 4); dst[0] = pg8::cvt_pk_bf16(xr0, xi0); dst[32] = pg8::cvt_pk_bf16(xr1, xi1); }
            }
            if (PASS == 2) {
                LDS_WAIT(); asm volatile("" ::: "memory");
#pragma unroll
                for (int mt = 0; mt < 2; ++mt) {
                    f32x4 ya = (f32x4){0.f, 0.f, 0.f, 0.f};
#pragma unroll
                    for (int kk = 0; kk < 4; ++kk) { const bf16x8 Xf = *(const LAS bf16x8*)(xl + ((lane & 15) + 16 * mt) * 272 + 64 * kk + 16 * (lane >> 4));
                        ya = __builtin_amdgcn_mfma_f32_16x16x32_bf16(Cf[kk], Xf, ya, 0, 0, 0); }
                    const size_t trow = (size_t)b * SEQ + (cp + 8 * mt) * 256 + sb * 16 + (lane & 15);
                    const unsigned long long uw = *(const GAS unsigned long long*)(QKVU + trow * 2048 + 1536 + g * 16 + 4 * (lane >> 4));
                    float y[4]; y[0] = ya[0] + dsk[0] * bflo((unsigned)uw); y[1] = ya[1] + dsk[1] * bfhi((unsigned)uw); y[2] = ya[2] + dsk[2] * bflo((unsigned)(uw >> 32)); y[3] = ya[3] + dsk[3] * bfhi((unsigned)(uw >> 32));
#pragma unroll
                    for (int i = 0; i < 4; ++i) { const float v = y[i]; y[i] = v * sigm_(1.5957691216057308f * (v + 0.044715f * v * v * v)); }
                    *(GAS unsigned long long*)(YS + trow * 512 + g * 16 + 4 * (lane >> 4)) = (unsigned long long)pk2(y[0], y[1]) | ((unsigned long long)pk2(y[2], y[3]) << 32);
                }
                LDS_WAIT(); asm volatile("" ::: "memory");
            }
            Af = An;
        }
        if (PASS == 1) { float* e = endp + (size_t)(((b * 32 + g) * 16 + cc)) * 128; e[q * 2] = xr0; e[q * 2 + 1] = xi0; e[(q + 32) * 2] = xr1; e[(q + 32) * 2 + 1] = xi1; }
    }
}

__device__ __forceinline__ void routing_phase(Frame& F) {
    LAS int* hist = (LAS int*)(F.lds + RING_OFF); LAS int* base = hist + 32;
    const float* logits = WSP(float, WS_LOGITS); int* list = WSP(int, WS_LIST); int* tok_e = WSP(int, WS_TOK); int* tok_r = tok_e + 2 * T; float* tok_w = (float*)(tok_r + 2 * T);
    const int tid = F.tid;
    for (int chunk = F.vcu; chunk < T / 256; chunk += F.G) {
        if (tid < 64) hist[tid] = 0;
        __syncthreads();
        int e1 = 0, e2 = 0, r1 = 0, r2 = 0; float w1 = 0.f, w2 = 0.f; const int tok = chunk * 256 + tid;
        if (tid < 256) {
            const float* lp = logits + (size_t)tok * 64;
            float lg[4]; { const f32x4 v = *(const f32x4*)lp; lg[0] = v.x + F.in[26][0]; lg[1] = v.y + F.in[26][1]; lg[2] = v.z + F.in[26][2]; lg[3] = v.w + F.in[26][3]; }
            int grp = 0; float mx = lg[0];
#pragma unroll
            for (int j = 1; j < 4; ++j) if (lg[j] > mx) { mx = lg[j]; grp = j; }
            float den = 0.f;
#pragma unroll
            for (int j = 0; j < 4; ++j) den += expf(lg[j] - mx);
            const float pg = 1.f / den;
            float le[8]; { const f32x4 a = *(const f32x4*)(lp + 4 + grp * 8), b = *(const f32x4*)(lp + 8 + grp * 8); const float* br = F.in[28] + grp * 8;
                le[0] = a.x + br[0]; le[1] = a.y + br[1]; le[2] = a.z + br[2]; le[3] = a.w + br[3]; le[4] = b.x + br[4]; le[5] = b.y + br[5]; le[6] = b.z + br[6]; le[7] = b.w + br[7]; }
            int i1 = 0; float v1 = le[0];
#pragma unroll
            for (int j = 1; j < 8; ++j) if (le[j] > v1) { v1 = le[j]; i1 = j; }
            int i2 = -1; float v2 = -INFINITY;
#pragma unroll
            for (int j = 0; j < 8; ++j) if (j != i1 && (i2 < 0 || le[j] > v2)) { v2 = le[j]; i2 = j; }
            const float ex = expf(v2 - v1), s1 = 1.f / (1.f + ex);
            w1 = pg * s1; w2 = pg * (ex * s1); e1 = grp * 8 + i1; e2 = grp * 8 + i2;
            r1 = __hip_atomic_fetch_add(&hist[e1], 1, __ATOMIC_RELAXED, __HIP_MEMORY_SCOPE_WORKGROUP); r2 = __hip_atomic_fetch_add(&hist[e2], 1, __ATOMIC_RELAXED, __HIP_MEMORY_SCOPE_WORKGROUP);
        }
        __syncthreads();
        if (tid < 32) base[tid] = (int)__hip_atomic_fetch_add((unsigned*)(F.ctl + CW_CNT) + tid, (unsigned)hist[tid], __ATOMIC_RELAXED, __HIP_MEMORY_SCOPE_AGENT);
        __syncthreads();
        if (tid < 256) { r1 += base[e1]; r2 += base[e2];
            list[(size_t)e1 * T + r1] = tok; list[(size_t)e2 * T + r2] = tok;
            tok_e[2 * tok] = e1; tok_e[2 * tok + 1] = e2; tok_r[2 * tok] = r1; tok_r[2 * tok + 1] = r2; tok_w[2 * tok] = w1; tok_w[2 * tok + 1] = w2; }
        __syncthreads();
    }
}
__device__ __forceinline__ int expert_tables(Frame& F) {
    LAS int* cnt = (LAS int*)(F.lds + TBL_CNT); LAS int* tstart = (LAS int*)(F.lds + TBL_TSTART); LAS int* tile_e = (LAS int*)(F.lds + TBL_TILE_E);
    if (F.tid < 32) cnt[F.tid] = (int)__hip_atomic_load((unsigned*)(F.ctl + CW_CNT) + F.tid, __ATOMIC_RELAXED, __HIP_MEMORY_SCOPE_AGENT);
    __syncthreads();
    if (F.tid == 0) { int s = 0; for (int e = 0; e < 32; ++e) { tstart[e] = s; s += (cnt[e] + 255) >> 8; } tstart[32] = s > 544 ? 544 : s; }
    __syncthreads();
    const int MT = tstart[32];
    for (int t = F.tid; t < MT; t += NWAVES * 64) { int e = 0; while (e < 31 && tstart[e + 1] <= t) ++e; tile_e[t] = e; }
    __syncthreads();
    return MT;
}
__device__ __forceinline__ void final_phase(Frame& F) {
    (void)expert_tables(F);
    const LAS int* tstart = (const LAS int*)(F.lds + TBL_TSTART);
    const int gw = F.vcu * NWAVES + F.wave, NGW = F.G * NWAVES, lane = F.lane;
    const float* x1 = WSP(float, WS_X1); const bf16* ys = WSP(bf16, WS_YS); const float* mod = WSP(float, WS_MOD);
    const int* tok_e = WSP(int, WS_TOK); const int* tok_r = tok_e + 2 * T; const float* tok_w = (const float*)(tok_r + 2 * T);
    for (int m = gw; m < T; m += NGW) {
        const int e0 = tok_e[2 * m], e1 = tok_e[2 * m + 1]; const size_t p0 = ((size_t)tstart[e0] << 8) + tok_r[2 * m], p1 = ((size_t)tstart[e1] << 8) + tok_r[2 * m + 1];
        const float w0 = tok_w[2 * m], w1 = tok_w[2 * m + 1];
        const GAS f32x4* xr = (const GAS f32x4*)(x1 + (size_t)m * D) + lane; const f32x4* g2 = (const f32x4*)(mod + (size_t)(m >> 12) * 6144 + 5120) + lane;
        const GAS unsigned long long* y0 = (const GAS unsigned long long*)(ys + p0 * 1024) + lane; const GAS unsigned long long* y1 = (const GAS unsigned long long*)(ys + p1 * 1024) + lane;
        f32x4 v[4]; float s = 0.f;
#pragma unroll
        for (int j = 0; j < 4; ++j) { const unsigned long long a = y0[64 * j], b = y1[64 * j]; const f32x4 gt = g2[64 * j]; f32x4 mo;
            mo.x = w0 * bflo((unsigned)a) + w1 * bflo((unsigned)b); mo.y = w0 * bfhi((unsigned)a) + w1 * bfhi((unsigned)b);
            mo.z = w0 * bflo((unsigned)(a >> 32)) + w1 * bflo((unsigned)(b >> 32)); mo.w = w0 * bfhi((unsigned)(a >> 32)) + w1 * bfhi((unsigned)(b >> 32));
            v[j] = xr[64 * j] + gt * mo; s += (v[j].x * v[j].x + v[j].y * v[j].y) + (v[j].z * v[j].z + v[j].w * v[j].w); }
        const float rstd = 1.f / sqrtf(wave_sum(s) * (1.f / D) + NORM_EPS);
        GAS f32x4* o = (GAS f32x4*)(F.out + (size_t)m * D) + lane;
#pragma unroll
        for (int j = 0; j < 4; ++j) o[64 * j] = v[j] * rstd * ((const f32x4*)F.in[31])[lane + 64 * j];
    }
}

struct Args { const float* in[32]; float* out; unsigned char* ws; int ph_lo, ph_hi; };
__global__ void __launch_bounds__(NWAVES * 64, 2) fwd(Args args) {
    extern __shared__ __attribute__((aligned(16))) unsigned char lds[];
    Frame F;
    F.lds = (LAS unsigned char*)lds;
    F.MISC = (volatile LAS unsigned*)(F.lds + MISC_OFF);
    F.tid = threadIdx.x; F.lane = F.tid & 63; F.wave = __builtin_amdgcn_readfirstlane(F.tid >> 6);
    F.G = gridDim.x; { const int bx = blockIdx.x; F.vcu = (F.G % 8 == 0) ? (bx % 8) * (F.G / 8) + bx / 8 : bx; }
#pragma unroll
    for (int i = 0; i < 32; ++i) F.in[i] = args.in[i];
    F.out = args.out; F.ws = args.ws; F.ctl = (gu32*)(args.ws + WS_CTL);
    for (int u = F.tid; u < 128; u += NWAVES * 64) ((LAS unsigned*)(F.lds + LDSCTL_OFF))[u] = 0u;
    __syncthreads();
    XcdBarrier bar; bar.bar = (unsigned*)(F.ctl + CW_BAR); bar.x = 0; bar.st = nullptr;
#if !MK_PER_PHASE
    bar = xcd_barrier_post((unsigned*)(F.ctl + CW_BAR), F.MISC + 8);
#define GRID_BAR() xcd_barrier(bar)
#else
#define GRID_BAR() do { } while (0)
#endif
    const int lo = args.ph_lo, hi = args.ph_hi;
#ifndef PHMASK
#define PHMASK 0x7fff
#endif
#define IN(k) (((PHMASK >> (k)) & 1) && lo <= (k) && (k) < hi)
#define SEAM(k) do { if (IN(k) && IN((k) + 1)) GRID_BAR(); } while (0)
    using pg8::bf16_t;
    if (IN(0)) { p0_prologue(F); } SEAM(0);
    if (IN(1)) { ln_phase(F, F.in[0], F.in[4], 0, 1024, WSP(bf16, WS_H1)); } SEAM(1);
    if (IN(2)) { pg8::Gemm g{WSP(bf16_t, WS_H1), WSP(bf16_t, WS_WIN), 1024}; pg8::StaticOrder S; S.init(T, 4096, F.G, (int)blockIdx.x);
        pg8::EpiInProj E{WSP(bf16_t, WS_QKVU), WSP(bf16_t, WS_GATES), 0.125f * LOG2E};
        pg8::gemm_phase<pg8::EpiInProj, pg8::StaticOrder, true>(F.lds + RING_OFF, g, S, E); } SEAM(2);
    if (IN(3)) {
        ssm_phase<1>(F);
        __syncthreads();
        { LAS float* tabs = (LAS float*)(F.lds + ATT_TAB_OFF); const float* tb = WSP(float, WS_TAB + TAB_BIAS); const float* b31g = WSP(float, WS_TAB + TAB_B31);
          for (int i = F.tid; i < 4 * attn_body::TABN; i += NWAVES * 64) tabs[i] = tb[i];
          if (F.tid < 4) tabs[4 * attn_body::TABN + F.tid] = b31g[F.tid]; }
        __syncthreads();
        const attn_body::AttnTensors AT{(const attn_body::bf16*)WSP(bf16, WS_QKVU), (attn_body::bf16*)WSP(bf16, WS_OV), (attn_body::lds_fptr)(F.lds + ATT_TAB_OFF), (attn_body::lds_fptr)(F.lds + ATT_TAB_OFF) + 4 * attn_body::TABN};
        const attn_body::StaticOrder S((int)F.G, F.vcu);
        attn_body::attn_phase<attn_body::StaticOrder>((char*)lds + RING_OFF, AT, S);
    } SEAM(3);
    if (IN(4)) { ssm_phase<2>(F); attn_combine_phase(F); } SEAM(4);
    if (IN(5)) { pg8::Gemm g{WSP(bf16_t, WS_YSSM), WSP(bf16_t, WS_WGLU), 512}; pg8::StaticOrder S; S.init(T, 1024, F.G, (int)blockIdx.x);
        pg8::EpiGate<0> E{WSP(bf16_t, WS_S), 512};
        pg8::gemm_phase<pg8::EpiGate<0>, pg8::StaticOrder, true>(F.lds + RING_OFF, g, S, E); } SEAM(5);
    if (IN(6)) { pg8::Gemm g{WSP(bf16_t, WS_YATTN), WSP(bf16_t, WS_WPA), 512}; pg8::StaticOrder S; S.init(T, 1024, F.G, (int)blockIdx.x);
        pg8::EpiGateMul E{WSP(bf16_t, WS_GATES), 0, nullptr, WSP(bf16_t, WS_TMP)};
        pg8::gemm_phase<pg8::EpiGateMul, pg8::StaticOrder, true>(F.lds + RING_OFF, g, S, E); } SEAM(6);
    if (IN(7)) { pg8::Gemm g{WSP(bf16_t, WS_S), WSP(bf16_t, WS_WPS), 512}; pg8::StaticOrder S; S.init(T, 1024, F.G, (int)blockIdx.x);
        pg8::EpiGateMul E{WSP(bf16_t, WS_GATES), 1024, WSP(bf16_t, WS_TMP), WSP(bf16_t, WS_MERGED)};
        pg8::gemm_phase<pg8::EpiGateMul, pg8::StaticOrder, true>(F.lds + RING_OFF, g, S, E); } SEAM(7);
    if (IN(8)) { pg8::Gemm g{WSP(bf16_t, WS_MERGED), WSP(bf16_t, WS_WOUT), 1024}; pg8::StaticOrder S; S.init(T, 1024, F.G, (int)blockIdx.x);
        pg8::EpiResid E{F.in[0], WSP(float, WS_MOD), WSP(float, WS_X1)};
        pg8::gemm_phase<pg8::EpiResid, pg8::StaticOrder, true>(F.lds + RING_OFF, g, S, E); } SEAM(8);
    if (IN(9)) { ln_phase(F, WSP(float, WS_X1), F.in[24], 3072, 4096, WSP(bf16, WS_H2)); } SEAM(9);
    if (IN(10)) { pg8::Gemm g{WSP(bf16_t, WS_H2), WSP(bf16_t, WS_WR), 1024}; pg8::StaticOrder S; S.init(T, 256, F.G, (int)blockIdx.x);
        pg8::EpiRouter E{WSP(float, WS_LOGITS)};
        pg8::gemm_phase<pg8::EpiRouter, pg8::StaticOrder, true>(F.lds + RING_OFF, g, S, E); } SEAM(10);
    if (IN(11)) { routing_phase(F); } SEAM(11);
    if (IN(12)) { const int MT = expert_tables(F);
        LAS int* rowtab = (LAS int*)(F.lds + TBL_ROWTAB); const LAS int* tile_e = (const LAS int*)(F.lds + TBL_TILE_E); const LAS int* tstart = (const LAS int*)(F.lds + TBL_TSTART); const LAS int* cnt = (const LAS int*)(F.lds + TBL_CNT);
        const int* list = WSP(int, WS_LIST);
        for (int ui = 0; ui < ROWTAB_UNITS; ++ui) { const int L = ui * F.G + F.vcu; if (L >= MT * 4) break;
            if (F.tid < 256) { const int mt = L >> 2, e = tile_e[mt], rank = ((mt - tstart[e]) << 8) + F.tid; rowtab[ui * 256 + F.tid] = rank < cnt[e] ? list[(size_t)e * T + rank] : 0; } }
        __syncthreads();
        pg8::Gemm g{WSP(bf16_t, WS_H2), WSP(bf16_t, WS_WE1), 1024}; pg8::ExpertOrder S{tile_e, rowtab, MT, F.G, F.vcu, true};
        pg8::EpiGate<1> E{WSP(bf16_t, WS_ACT), 512};
        pg8::gemm_phase<pg8::EpiGate<1>, pg8::ExpertOrder, true>(F.lds + RING_OFF, g, S, E); } SEAM(12);
    if (IN(13)) { const int MT = expert_tables(F);
        const LAS int* tile_e = (const LAS int*)(F.lds + TBL_TILE_E);
        pg8::Gemm g{WSP(bf16_t, WS_ACT), WSP(bf16_t, WS_WE2), 512}; pg8::ExpertOrder S{tile_e, nullptr, MT, F.G, F.vcu, false};
        pg8::EpiPlain E{WSP(bf16_t, WS_YS), 1024};
        pg8::gemm_phase<pg8::EpiPlain, pg8::ExpertOrder, true>(F.lds + RING_OFF, g, S, E); } SEAM(13);
    if (IN(14)) { final_phase(F); }
#undef IN
#undef SEAM
}

extern "C" void kernel_launch(void* const* d_in, const int* in_sizes, int n_in, void* d_out, int out_size, void* d_ws, size_t ws_size, hipStream_t stream) {
    static int grid = 0;
    if (grid == 0) {
        if (n_in != 32 || out_size != T * D || ws_size < WS_END) { fprintf(stderr, "kernel_launch: unexpected shapes (n_in %d out %d ws %zu)\n", n_in, out_size, ws_size); grid = -1; return; }
        int dev = 0, cus = 0, per_cu = 0;
        if (hipGetDevice(&dev) != hipSuccess || hipDeviceGetAttribute(&cus, hipDeviceAttributeMultiprocessorCount, dev) != hipSuccess) { grid = -1; return; }
        if (hipFuncSetAttribute((const void*)fwd, hipFuncAttributeMaxDynamicSharedMemorySize, LDS_BYTES) != hipSuccess) { fprintf(stderr, "kernel_launch: hipFuncSetAttribute failed\n"); grid = -1; return; }
        if (hipOccupancyMaxActiveBlocksPerMultiprocessor(&per_cu, (const void*)fwd, NWAVES * 64, LDS_BYTES) != hipSuccess || per_cu < 1) fprintf(stderr, "kernel_launch: occupancy query reports %d\n", per_cu);
        (void)hipGetLastError();
        grid = cus;
    }
    if (grid < 0) return;
    if (hipMemsetAsync((char*)d_ws + WS_CTL, 0, CTL_ZERO_BYTES, stream) != hipSuccess) return;
    Args a{};
    for (int i = 0; i < 32; ++i) a.in[i] = (const float*)d_in[i];
    a.out = (float*)d_out; a.ws = (unsigned char*)d_ws;
#if MK_PER_PHASE
    for (int p = 0; p < NPH; ++p) { a.ph_lo = p; a.ph_hi = p + 1; hipLaunchKernelGGL(fwd, dim3(grid), dim3(NWAVES * 64), LDS_BYTES, stream, a); }
#else
    a.ph_lo = 0; a.ph_hi = NPH; hipLaunchKernelGGL(fwd, dim3(grid), dim3(NWAVES * 64), LDS_BYTES, stream, a);
#endif
}
```

```cpp
#include <hip/hip_runtime.h>
#include <hip/hip_bf16.h>
#include <cstdio>
#include <cstdint>
#include <cmath>

#ifndef MK_PER_PHASE
#define MK_PER_PHASE 0
#endif

namespace pg8 {
#define PG8_LAS __attribute__((address_space(3)))
typedef unsigned short bf16_t;
typedef short bf16x8 __attribute__((ext_vector_type(8)));
typedef float f32x4 __attribute__((ext_vector_type(4)));
typedef unsigned u32x4 __attribute__((ext_vector_type(4)));
constexpr int BM = 256, BK = 64, HALF = 128, HTB = HALF * BK * 2  , STAGE_BYTES = 8 * HTB, NXCD = 8, WGM = 8;

__host__ __device__ __forceinline__ int lds_byte(int r, int c) { const int st = (r >> 4) * 2 + (c >> 5), rr = r & 15, cc = c & 31, ob = rr * 64 + cc * 2; return st * 1024 + (ob ^ (((ob >> 9) & 1) << 5)); }
__host__ __device__ __forceinline__ void stage_rc(int b, int& R, int& C) { const int st = b / 1024, sb = b % 1024, swz = sb ^ (((sb >> 9) & 1) << 5); R = (st >> 1) * 16 + swz / 64; C = (st & 1) * 32 + (swz % 64) / 2; }
__host__ __device__ __forceinline__ int perm32(int rho) { const int n = rho >> 4, i = rho & 15; return 8 * (i >> 2) + 4 * n + (i & 3); }

struct Unit { int pm, pn, pc, seg; };
struct Gemm { const bf16_t* A; const bf16_t* Bt; int K; };

struct StaticOrder {
    int nM, nN, nwg, G, c;
    __host__ __device__ void init(int M, int N, int G_, int c_) { nM = M / BM; nN = N / BM; nwg = nM * nN; G = G_; c = c_; }
    __host__ __device__ bool next(int i, Unit& u) const {
        const long L = (long)i * G + c; if (L >= nwg) return false;
        int wgid = (int)L; { const int q = nwg / NXCD, r = nwg % NXCD, xcd = wgid % NXCD, off = wgid / NXCD; wgid = (xcd < r ? xcd * (q + 1) : r * (q + 1) + (xcd - r) * q) + off; }
        const int nig = WGM * nN, gid = wgid / nig, fm = gid * WGM, gsz = (nM - fm) < WGM ? (nM - fm) : WGM;
        u.pm = fm + ((wgid % nig) % gsz); u.pn = (wgid % nig) / gsz; u.pc = u.pn; u.seg = 0; return true;
    }
    __device__ __forceinline__ void arows(const Unit& u, int, int R0, int R1, unsigned (&r)[2][2]) const {
        r[0][0] = u.pm * BM + R0; r[0][1] = u.pm * BM + R1; r[1][0] = u.pm * BM + HALF + R0; r[1][1] = u.pm * BM + HALF + R1; }
};
struct ChainOrder {
    StaticOrder so; unsigned arow_off; int bt_off;
    __device__ __forceinline__ bool next(int i, Unit& u) const { if (!so.next(i >> 1, u)) return false; u.seg = i & 1; if (u.seg) u.pn += bt_off; return true; }
    __device__ __forceinline__ void arows(const Unit& u, int, int R0, int R1, unsigned (&r)[2][2]) const {
        const unsigned b = u.pm * BM + (u.seg ? arow_off : 0u); r[0][0] = b + R0; r[0][1] = b + R1; r[1][0] = b + HALF + R0; r[1][1] = b + HALF + R1; }
};
struct ExpertOrder {
    const PG8_LAS int* tile_e; const PG8_LAS int* rowtab; int MT, G, c; bool gather;
    __device__ __forceinline__ bool next(int i, Unit& u) const {
        const int L = i * G + c; if (L >= MT * 4) return false;
        const int mt = L >> 2, nt = L & 3; const int e = tile_e[mt]; u.pm = mt; u.pn = e * 4 + nt; u.pc = nt; u.seg = 0; return true; }
    __device__ __forceinline__ void arows(const Unit& u, int ui, int R0, int R1, unsigned (&r)[2][2]) const {
        if (gather) { const PG8_LAS int* t = rowtab + ui * BM; r[0][0] = (unsigned)t[R0]; r[0][1] = (unsigned)t[R1]; r[1][0] = (unsigned)t[HALF + R0]; r[1][1] = (unsigned)t[HALF + R1]; }
        else { r[0][0] = u.pm * BM + R0; r[0][1] = u.pm * BM + R1; r[1][0] = u.pm * BM + HALF + R0; r[1][1] = u.pm * BM + HALF + R1; } }
};

__device__ __forceinline__ unsigned cvt_pk_bf16(float lo, float hi) { unsigned r; asm volatile("v_cvt_pk_bf16_f32 %0, %1, %2" : "=v"(r) : "v"(lo), "v"(hi)); return r; }
__device__ __forceinline__ float bf_lo(unsigned w) { return __uint_as_float(w << 16); }
__device__ __forceinline__ float bf_hi(unsigned w) { return __uint_as_float(w & 0xffff0000u); }
__device__ __forceinline__ float sigm(float x) { return __builtin_amdgcn_rcpf(1.f + __builtin_amdgcn_exp2f(-1.4426950408889634f * x)); }
__device__ __forceinline__ u32x4 pack8(const f32x4& v0, const f32x4& v1) { u32x4 w; w.x = cvt_pk_bf16(v0[0], v0[1]); w.y = cvt_pk_bf16(v0[2], v0[3]); w.z = cvt_pk_bf16(v1[0], v1[1]); w.w = cvt_pk_bf16(v1[2], v1[3]); return w; }

struct EpiInProj { static constexpr bool PERM = true;
    bf16_t* qkvu; bf16_t* gates; float qscale;
    __device__ __forceinline__ bool operator()(f32x4 (&acc)[2][2][4][2], const Unit& u, int wr, int wc, int fr, int fq) const {
        const int row0 = u.pm * BM + wr * 64 + fr; const bool isg = u.pc >= 8;
        bf16_t* base = isg ? gates : qkvu; const int col0 = (u.pc & 7) * BM + wc * 32 + 8 * fq; const float sc = (u.pc < 2) ? qscale : 1.f;
#pragma unroll
        for (int ai = 0; ai < 2; ++ai)
#pragma unroll
            for (int m = 0; m < 4; ++m) { bf16_t* rowp = base + (size_t)(row0 + ai * HALF + m * 16) * 2048 + col0;
#pragma unroll
                for (int bj = 0; bj < 2; ++bj) { f32x4 v0 = acc[ai][bj][m][0], v1 = acc[ai][bj][m][1];
                    if (isg) {
#pragma unroll
                        for (int i = 0; i < 4; ++i) { v0[i] = sigm(v0[i]); v1[i] = sigm(v1[i]); } }
                    else { v0 = v0 * sc; v1 = v1 * sc; }
                    *(u32x4*)(rowp + bj * HALF) = pack8(v0, v1); } }
        return false;
    }
};
template <int MODE> struct EpiGate { static constexpr bool PERM = true;
    bf16_t* O; int ldc;
    __device__ __forceinline__ bool operator()(f32x4 (&acc)[2][2][4][2], const Unit& u, int wr, int wc, int fr, int fq) const {
        const int row0 = u.pm * BM + wr * 64 + fr; const int col0 = u.pc * HALF + wc * 32 + 8 * fq;
#pragma unroll
        for (int ai = 0; ai < 2; ++ai)
#pragma unroll
            for (int m = 0; m < 4; ++m) { f32x4 r0, r1;
#pragma unroll
                for (int i = 0; i < 4; ++i) { const float a0 = acc[ai][0][m][0][i], a1 = acc[ai][0][m][1][i], g0 = acc[ai][1][m][0][i], g1 = acc[ai][1][m][1][i];
                    if (MODE == 0) { r0[i] = a0 * sigm(g0); r1[i] = a1 * sigm(g1); } else { r0[i] = a0 * sigm(a0) * g0; r1[i] = a1 * sigm(a1) * g1; } }
                *(u32x4*)(O + (size_t)(row0 + ai * HALF + m * 16) * ldc + col0) = pack8(r0, r1); }
        return false;
    }
};
struct EpiMerge { static constexpr bool PERM = true;
    const bf16_t* gates; bf16_t* out;
    __device__ __forceinline__ bool operator()(f32x4 (&acc)[2][2][4][2], const Unit& u, int wr, int wc, int fr, int fq) const {
        const int row0 = u.pm * BM + wr * 64 + fr; const int col0 = u.pc * BM + wc * 32 + 8 * fq;
#pragma unroll
        for (int ai = 0; ai < 2; ++ai)
#pragma unroll
            for (int m = 0; m < 4; ++m) { const size_t r = (size_t)(row0 + ai * HALF + m * 16);
#pragma unroll
                for (int bj = 0; bj < 2; ++bj) { const int c = col0 + bj * HALF;
                    const u32x4 gs = *(const u32x4*)(gates + r * 2048 + 1024 + c);
                    f32x4 s0, s1; s0[0] = bf_lo(gs.x); s0[1] = bf_hi(gs.x); s0[2] = bf_lo(gs.y); s0[3] = bf_hi(gs.y); s1[0] = bf_lo(gs.z); s1[1] = bf_hi(gs.z); s1[2] = bf_lo(gs.w); s1[3] = bf_hi(gs.w);
                    if (u.seg == 0) { const u32x4 ga = *(const u32x4*)(gates + r * 2048 + c);
                        f32x4 a0, a1; a0[0] = bf_lo(ga.x); a0[1] = bf_hi(ga.x); a0[2] = bf_lo(ga.y); a0[3] = bf_hi(ga.y); a1[0] = bf_lo(ga.z); a1[1] = bf_hi(ga.z); a1[2] = bf_lo(ga.w); a1[3] = bf_hi(ga.w);
#pragma unroll
                        for (int i = 0; i < 4; ++i) { acc[ai][bj][m][0][i] *= a0[i] / s0[i]; acc[ai][bj][m][1][i] *= a1[i] / s1[i]; } }
                    else { *(u32x4*)(out + r * 1024 + c) = pack8(acc[ai][bj][m][0] * s0, acc[ai][bj][m][1] * s1); } } }
        return u.seg == 0;
    }
};
struct EpiResid { static constexpr bool PERM = true;
    const float* x; const float* mod; bf16_t* x1;
    __device__ __forceinline__ bool operator()(f32x4 (&acc)[2][2][4][2], const Unit& u, int wr, int wc, int fr, int fq) const {
        const int row0 = u.pm * BM + wr * 64 + fr; const int col0 = u.pc * BM + wc * 32 + 8 * fq; const float* gp = mod + (size_t)(u.pm >> 4) * 6144 + 2048;
        f32x4 gv[2][2];
#pragma unroll
        for (int bj = 0; bj < 2; ++bj) { gv[bj][0] = *(const f32x4*)(gp + col0 + bj * HALF); gv[bj][1] = *(const f32x4*)(gp + col0 + bj * HALF + 4); }
#pragma unroll
        for (int ai = 0; ai < 2; ++ai)
#pragma unroll
            for (int m = 0; m < 4; ++m) { const size_t off = (size_t)(row0 + ai * HALF + m * 16) * 1024 + col0;
#pragma unroll
                for (int bj = 0; bj < 2; ++bj) { const f32x4 x0 = *(const f32x4*)(x + off + bj * HALF), x1v = *(const f32x4*)(x + off + bj * HALF + 4);
                    *(u32x4*)(x1 + off + bj * HALF) = pack8(x0 + gv[bj][0] * acc[ai][bj][m][0], x1v + gv[bj][1] * acc[ai][bj][m][1]); } }
        return false;
    }
};
struct EpiRouter { static constexpr bool PERM = true;
    float* logits;
    __device__ __forceinline__ bool operator()(f32x4 (&acc)[2][2][4][2], const Unit& u, int wr, int wc, int fr, int fq) const {
        if (wc >= 2) return false;
        const int row0 = u.pm * BM + wr * 64 + fr; const int col0 = wc * 32 + 8 * fq;
#pragma unroll
        for (int ai = 0; ai < 2; ++ai)
#pragma unroll
            for (int m = 0; m < 4; ++m) { float* p = logits + (size_t)(row0 + ai * HALF + m * 16) * 64 + col0; *(f32x4*)p = acc[ai][0][m][0]; *(f32x4*)(p + 4) = acc[ai][0][m][1]; }
        return false;
    }
};
struct EpiPlain { static constexpr bool PERM = true;
    bf16_t* O; int ldc;
    __device__ __forceinline__ bool operator()(f32x4 (&acc)[2][2][4][2], const Unit& u, int wr, int wc, int fr, int fq) const {
        const int row0 = u.pm * BM + wr * 64 + fr; const int col0 = u.pc * BM + wc * 32 + 8 * fq;
#pragma unroll
        for (int ai = 0; ai < 2; ++ai)
#pragma unroll
            for (int m = 0; m < 4; ++m) { bf16_t* rowp = O + (size_t)(row0 + ai * HALF + m * 16) * ldc + col0;
#pragma unroll
                for (int bj = 0; bj < 2; ++bj) *(u32x4*)(rowp + bj * HALF) = pack8(acc[ai][bj][m][0], acc[ai][bj][m][1]); }
        return false;
    }
};

template <class Epi, class Sched, bool ALIGN_EPI>
__device__ __forceinline__ void gemm_phase(PG8_LAS unsigned char* lds, const Gemm g, const Sched& S, const Epi& E) {
    const int tid = threadIdx.x, wid = __builtin_amdgcn_readfirstlane(tid >> 6), lane = tid & 63, wr = wid >> 2, wc = wid & 3, fr = lane & 15, fq = lane >> 4;
    const int K = g.K, nt = K / BK;
    int Rr[2], Cc[2]; unsigned voffB[2];
#pragma unroll
    for (int i = 0; i < 2; ++i) { int R, C; stage_rc(tid * 16 + i * 8192, R, C); const int Rb = Epi::PERM ? ((R & ~31) + perm32(R & 31)) : R;
        Rr[i] = R; Cc[i] = C; voffB[i] = (unsigned)(Rb * K + C) * 2u; }
    const size_t kstep = (size_t)(BK * 2);
    const size_t hstep = (size_t)HALF * K * 2;
    const size_t tstep = 2 * hstep;
    const unsigned ldsw = (unsigned)wid * 1024u;
    const int aoff = lds_byte(wr * 64 + fr, fq * 8), boff = lds_byte(wc * 32 + fr, fq * 8);
#define PG8_SA(b, h) (((b) * 2 + (h)) * HTB)
#define PG8_SB(b, h) ((4 + (b) * 2 + (h)) * HTB)
#define PG8_STAGE(bufoff, gbase, voff) do { _Pragma("unroll") for (int _i = 0; _i < 2; ++_i) \
        __builtin_amdgcn_global_load_lds((const unsigned*)((const char*)(gbase) + (voff)[_i]), (PG8_LAS unsigned*)(lds + (bufoff) + ldsw + _i * 8192), 16, 0, 0); } while (0)
#define PG8_LDA(dst, b, h) do { _Pragma("unroll") for (int m = 0; m < 4; ++m) _Pragma("unroll") for (int k = 0; k < 2; ++k) dst[m][k] = *(const PG8_LAS bf16x8*)(lds + PG8_SA(b, h) + aoff + m * 2048 + k * 1024); } while (0)
#define PG8_LDB(dst, b, h) do { _Pragma("unroll") for (int n = 0; n < 2; ++n) _Pragma("unroll") for (int k = 0; k < 2; ++k) dst[n][k] = *(const PG8_LAS bf16x8*)(lds + PG8_SB(b, h) + boff + n * 2048 + k * 1024); } while (0)
#define PG8_MMA(ai, bj, At, Bt) do { __builtin_amdgcn_s_setprio(1); _Pragma("unroll") for (int m = 0; m < 4; ++m) _Pragma("unroll") for (int n = 0; n < 2; ++n) _Pragma("unroll") for (int k = 0; k < 2; ++k) \
        acc[ai][bj][m][n] = __builtin_amdgcn_mfma_f32_16x16x32_bf16(Bt[n][k], At[m][k], acc[ai][bj][m][n], 0, 0, 0); __builtin_amdgcn_s_setprio(0); } while (0)
#define PG8_WAIT_V(n) asm volatile("s_waitcnt vmcnt(" #n ")" ::: "memory")
#define PG8_WAIT_L(n) asm volatile("s_waitcnt lgkmcnt(" #n ")" ::: "memory")
#define PG8_BAR __builtin_amdgcn_s_barrier()
#define PG8_SCHED __builtin_amdgcn_sched_barrier(0)
#define PG8_MKOFF(u_, ui_, v_) do { unsigned r_[2][2]; S.arows(u_, ui_, Rr[0], Rr[1], r_); _Pragma("unroll") for (int h_ = 0; h_ < 2; ++h_) _Pragma("unroll") for (int i_ = 0; i_ < 2; ++i_) \
        v_[h_][i_] = (r_[h_][i_] * (unsigned)K + (unsigned)Cc[i_]) * 2u; } while (0)
    Unit cur, nxt; int ui = 0;
    if (!S.next(0, cur)) return;
    unsigned vc[2][2], vn[2][2];
    PG8_MKOFF(cur, 0, vc);
    f32x4 acc[2][2][4][2];
#pragma unroll
    for (int a = 0; a < 2; ++a)
#pragma unroll
        for (int b = 0; b < 2; ++b)
#pragma unroll
            for (int m = 0; m < 4; ++m)
#pragma unroll
                for (int n = 0; n < 2; ++n) acc[a][b][m][n] = (f32x4){0.f, 0.f, 0.f, 0.f};
    bf16x8 At[4][2], B0[2][2], B1[2][2];
    const char* Ab = (const char*)g.A; const char* cB = (const char*)g.Bt + (size_t)cur.pn * tstep;
    PG8_STAGE(PG8_SB(0, 0), cB, voffB); PG8_STAGE(PG8_SB(0, 1), cB + hstep, voffB); PG8_STAGE(PG8_SA(0, 0), Ab, vc[0]); PG8_STAGE(PG8_SA(0, 1), Ab, vc[1]);
    if (wr == 1) PG8_BAR;
    PG8_WAIT_V(2); PG8_BAR;
    PG8_STAGE(PG8_SB(1, 0), cB + kstep, voffB); PG8_STAGE(PG8_SA(1, 0), Ab + kstep, vc[0]); PG8_STAGE(PG8_SB(1, 1), cB + hstep + kstep, voffB);
    PG8_WAIT_V(6); PG8_BAR;
    for (;;) {
        const bool has_next = S.next(ui + 1, nxt);
        if (has_next) { PG8_MKOFF(nxt, ui + 1, vn); } else { vn[0][0] = vc[0][0]; vn[0][1] = vc[0][1]; vn[1][0] = vc[1][0]; vn[1][1] = vc[1][1]; }
        const char* nB = has_next ? (const char*)g.Bt + (size_t)nxt.pn * tstep : cB;
        for (int t = 0; t < nt; t += 2) {
            const bool last = (t == nt - 2);
            const char* a1 = Ab + (size_t)(t + 1) * kstep;
            const char* a2 = last ? Ab : Ab + (size_t)(t + 2) * kstep; const char* b2 = last ? nB : cB + (size_t)(t + 2) * kstep;
            const char* a3 = a2 + kstep; const char* b3 = b2 + kstep;
            unsigned vs[2][2];
#pragma unroll
            for (int h = 0; h < 2; ++h)
#pragma unroll
                for (int i = 0; i < 2; ++i) vs[h][i] = last ? vn[h][i] : vc[h][i];
            PG8_LDB(B0, 0, 0); PG8_LDB(B1, 0, 1); PG8_SCHED; PG8_LDA(At, 0, 0); PG8_STAGE(PG8_SA(1, 1), a1, vc[1]);
            PG8_WAIT_V(8); PG8_WAIT_L(0); PG8_BAR; PG8_MMA(0, 0, At, B0); PG8_MMA(0, 1, At, B1); PG8_BAR; PG8_SCHED;
            PG8_LDA(At, 0, 1); PG8_STAGE(PG8_SB(0, 0), b2, voffB); PG8_STAGE(PG8_SB(0, 1), b2 + hstep, voffB); PG8_STAGE(PG8_SA(0, 0), a2, vs[0]);
            PG8_WAIT_V(8); PG8_WAIT_L(0); PG8_BAR; PG8_MMA(1, 0, At, B0); PG8_MMA(1, 1, At, B1); PG8_BAR; PG8_SCHED;
            PG8_LDB(B0, 1, 0); PG8_LDB(B1, 1, 1); PG8_SCHED; PG8_LDA(At, 1, 0); PG8_STAGE(PG8_SA(0, 1), a2, vs[1]);
            PG8_WAIT_V(8); PG8_WAIT_L(0); PG8_BAR; PG8_MMA(0, 0, At, B0); PG8_MMA(0, 1, At, B1); PG8_BAR; PG8_SCHED;
            PG8_LDA(At, 1, 1); PG8_STAGE(PG8_SB(1, 0), b3, voffB); PG8_STAGE(PG8_SB(1, 1), b3 + hstep, voffB); PG8_STAGE(PG8_SA(1, 0), a3, vs[0]);
            PG8_WAIT_V(8); PG8_WAIT_L(0); PG8_BAR; PG8_MMA(1, 0, At, B0); PG8_MMA(1, 1, At, B1); PG8_BAR; PG8_SCHED;
        }
        if constexpr (ALIGN_EPI) { if (wr == 0) PG8_BAR; }
        const bool keep = E(acc, cur, wr, wc, fr, fq);
        if (!has_next) break;
        if (!keep) {
#pragma unroll
        for (int a = 0; a < 2; ++a)
#pragma unroll
            for (int b = 0; b < 2; ++b)
#pragma unroll
                for (int m = 0; m < 4; ++m)
#pragma unroll
                    for (int n = 0; n < 2; ++n) acc[a][b][m][n] = (f32x4){0.f, 0.f, 0.f, 0.f};
        }
        cur = nxt; cB = nB; ++ui;
        vc[0][0] = vn[0][0]; vc[0][1] = vn[0][1]; vc[1][0] = vn[1][0]; vc[1][1] = vn[1][1];
        if constexpr (ALIGN_EPI) { if (wr == 1) PG8_BAR; }
    }
    PG8_WAIT_V(0);
    if constexpr (!ALIGN_EPI) { if (wr == 0) PG8_BAR; }
    PG8_BAR;
#undef PG8_SA
#undef PG8_SB
#undef PG8_STAGE
#undef PG8_LDA
#undef PG8_LDB
#undef PG8_MMA
#undef PG8_WAIT_V
#undef PG8_WAIT_L
#undef PG8_BAR
#undef PG8_SCHED
#undef PG8_MKOFF
}
}

namespace attn_body {
using bf16=__hip_bfloat16;
using bf16x8=__attribute__((ext_vector_type(8)))short;
using s16x4=__attribute__((ext_vector_type(4)))short;
using f32x16=__attribute__((ext_vector_type(16)))float;
using u32x4=__attribute__((ext_vector_type(4)))unsigned;
constexpr int BATCH=16,NHEAD=16,SEQ=4096,D=64,DM=NHEAD*D;
constexpr int PQ=2048;
constexpr int TABN=640;
constexpr int NW=8,QBLK=32,QB=QBLK*NW,KVBLK=64,NQB=SEQ/QB;
constexpr int ATTN_PITCH=DM, ATTN_UNIT_ROWS=QB;
__device__ __forceinline__ int crow(int r,int hi){return (r&3)+8*(r>>2)+4*hi;}
#define SBAR() __builtin_amdgcn_sched_barrier(0)
typedef __attribute__((address_space(3))) const float* lds_fptr;
__device__ __forceinline__ void cmask(f32x16&p0,f32x16&p1,int dt,int qrel,int hi,lds_fptr tab){
  lds_fptr t=tab+(64*dt+qrel-4*hi+255-59);
  #pragma unroll
  for(int r=0;r<16;++r){p0[r]+=t[59-((r&3)+8*(r>>2))]; p1[r]+=t[27-((r&3)+8*(r>>2))];}
}
constexpr int NSLOT=3, SLOTB=8192;
constexpr int LDS_K=0, LDS_V=NSLOT*SLOTB, LDS_WS=2*NSLOT*SLOTB, LDS_OST=LDS_WS+NW*64*4, LDS_BYTES=LDS_OST+NW*4096;
constexpr float C2=0.125f*1.4426950408889634f;
__device__ __forceinline__ void glds16(const void*gsrc,unsigned lds_dst){unsigned keep;
  asm volatile("s_mov_b32 %0, m0\n\ts_mov_b32 m0, %2\n\ts_nop 0\n\tglobal_load_lds_dwordx4 %1, off\n\ts_mov_b32 m0, %0":"=&s"(keep):"v"(gsrc),"s"(lds_dst):"memory");}
__device__ __forceinline__ float max3f(float a,float b,float c){float r;asm("v_max3_f32 %0, %1, %2, %3":"=v"(r):"v"(a),"v"(b),"v"(c));return r;}
__device__ __forceinline__ float max2f(float a,float b){float r;asm("v_max_f32_e32 %0, %1, %2":"=v"(r):"v"(a),"v"(b));return r;}
__device__ __forceinline__ float fadd_s(float a,float b){float r;asm("v_add_f32_e32 %0, %1, %2":"=v"(r):"v"(a),"v"(b));return r;}
__device__ __forceinline__ float fsub_s(float a,float b){float r;asm("v_sub_f32_e32 %0, %1, %2":"=v"(r):"v"(a),"v"(b));return r;}
typedef float f32x2_t __attribute__((ext_vector_type(2))); typedef __bf16 bf16x2_t __attribute__((ext_vector_type(2)));
__device__ __forceinline__ unsigned cvtpk_s(float lo,float hi){f32x2_t v={lo,hi};bf16x2_t b=__builtin_convertvector(v,bf16x2_t);return __builtin_bit_cast(unsigned,b);}
#define WAIT_BAR(N) asm volatile("s_waitcnt vmcnt(" #N ") lgkmcnt(0)\n\ts_barrier":::"memory")

__device__ __forceinline__ void qkt(f32x16&p0,f32x16&p1,const char*Kslot,const bf16x8*qr,const f32x16&negm,int r32,int hi){
  const char*kb=Kslot+hi*1024+r32*16;
  #pragma unroll
  for(int d0=0;d0<4;++d0){
    const bf16x8 b0=*reinterpret_cast<const bf16x8*>(kb+d0*2048);
    const bf16x8 b1=*reinterpret_cast<const bf16x8*>(kb+d0*2048+512);
    if(d0==0){p0=__builtin_amdgcn_mfma_f32_32x32x16_bf16(b0,qr[0],negm,0,0,0);p1=__builtin_amdgcn_mfma_f32_32x32x16_bf16(b1,qr[0],negm,0,0,0);}
    else{p0=__builtin_amdgcn_mfma_f32_32x32x16_bf16(b0,qr[d0],p0,0,0,0);p1=__builtin_amdgcn_mfma_f32_32x32x16_bf16(b1,qr[d0],p1,0,0,0);}}
}
typedef __attribute__((address_space(3))) const char* lds_cptr;
typedef short v4i16_t __attribute__((ext_vector_type(4)));
__device__ __forceinline__ void kload8(bf16x8*kf,lds_cptr kp){
  kf[0]=*(const __attribute__((address_space(3))) bf16x8*)(kp);      kf[1]=*(const __attribute__((address_space(3))) bf16x8*)(kp+512);
  kf[2]=*(const __attribute__((address_space(3))) bf16x8*)(kp+2048); kf[3]=*(const __attribute__((address_space(3))) bf16x8*)(kp+2560);
  kf[4]=*(const __attribute__((address_space(3))) bf16x8*)(kp+4096); kf[5]=*(const __attribute__((address_space(3))) bf16x8*)(kp+4608);
  kf[6]=*(const __attribute__((address_space(3))) bf16x8*)(kp+6144); kf[7]=*(const __attribute__((address_space(3))) bf16x8*)(kp+6656);
}
__device__ __forceinline__ void kload2(bf16x8*kf,lds_cptr kp,int j){ kf[2*j]=*(const __attribute__((address_space(3))) bf16x8*)(kp+j*2048); kf[2*j+1]=*(const __attribute__((address_space(3))) bf16x8*)(kp+j*2048+512); }
__device__ __forceinline__ s16x4 vtr(lds_cptr p){ return __builtin_bit_cast(s16x4,__builtin_amdgcn_ds_read_tr16_b64_v4i16((__attribute__((address_space(3))) v4i16_t*)p)); }
__device__ __forceinline__ float rowmax(const f32x16&p0,const f32x16&p1){
  float a=max3f(p0[0],p0[1],p1[0]),b=max3f(p0[2],p0[3],p1[1]);a=max3f(a,p1[2],p1[3]);
  #pragma unroll
  for(int r=4;r<16;r+=4){a=max3f(a,p0[r],p0[r+1]);b=max3f(b,p0[r+2],p0[r+3]);a=max3f(a,p1[r],p1[r+1]);b=max3f(b,p1[r+2],p1[r+3]);}
  const float m=max2f(a,b);
  auto rr=__builtin_amdgcn_permlane32_swap(__float_as_uint(m),__float_as_uint(m),false,false);
  return max2f(__uint_as_float(rr[0]),__uint_as_float(rr[1]));
}
__device__ __forceinline__ void pv(f32x16*o,int vb,bf16x8 pa0,bf16x8 pa1,bf16x8 pa2,bf16x8 pa3){
  #pragma unroll
  for(int d0=0;d0<2;++d0){s16x4 lo[4],hi[4];
    #pragma unroll
    for(int ks=0;ks<4;++ks){
      asm volatile("ds_read_b64_tr_b16 %0,%1 offset:%c2":"=&v"(lo[ks]):"v"(vb),"i"(d0*4096+ks*1024):"memory");
      asm volatile("ds_read_b64_tr_b16 %0,%1 offset:%c2":"=&v"(hi[ks]):"v"(vb),"i"(d0*4096+ks*1024+512):"memory");}
    asm volatile("s_waitcnt lgkmcnt(0)":::"memory");SBAR();
    #define PK(k) (bf16x8){lo[k][0],lo[k][1],lo[k][2],lo[k][3],hi[k][0],hi[k][1],hi[k][2],hi[k][3]}
    o[d0]=__builtin_amdgcn_mfma_f32_32x32x16_bf16(pa0,PK(0),o[d0],0,0,0);
    o[d0]=__builtin_amdgcn_mfma_f32_32x32x16_bf16(pa1,PK(1),o[d0],0,0,0);
    o[d0]=__builtin_amdgcn_mfma_f32_32x32x16_bf16(pa2,PK(2),o[d0],0,0,0);
    o[d0]=__builtin_amdgcn_mfma_f32_32x32x16_bf16(pa3,PK(3),o[d0],0,0,0);
    #undef PK
  }
}

#ifndef ATTN_STORE16
#define ATTN_STORE16(p,v) (*(u32x4*)(p)=(v))
#endif
template<int THRL> __device__ __forceinline__ void attn_unit(int b,int vh,int qb,const bf16*__restrict__ QKV,bf16*O,char*shm,lds_fptr tab,float b31){
  const int tid=threadIdx.x,lane=tid&63,r32=lane&31,hi=lane>>5; const int wid=__builtin_amdgcn_readfirstlane(tid>>6);
  const long rowbase=(long)b*SEQ; const int q0=qb*QB;
  const int hh=vh>>2,mm=(vh>>1)&1,vhalf=vh&1;
  const bf16*Qw=QKV+(rowbase+q0+wid*QBLK)*PQ+hh*128+mm*64;
  const bf16*Kh=QKV+rowbase*PQ+512+hh*128+mm*64,*Vh=QKV+rowbase*PQ+1024+hh*128+vhalf*64;
  const unsigned lds0=(unsigned)(uintptr_t)shm;
  float*wsf=(float*)(shm+LDS_WS)+wid*64;
  const bf16*ksrc=Kh+(long)lane*PQ+wid*8;
  const bf16*vsrc=Vh+(long)(16*(wid&3)+(lane>>2))*PQ+(wid>>2)*32+(lane&3)*8;
  const unsigned kdst=lds0+LDS_K+wid*1024, vdst=lds0+LDS_V+wid*1024;
  #define DMA_K(t,slot) glds16(ksrc+(long)(t)*KVBLK*PQ,(unsigned)__builtin_amdgcn_readfirstlane(kdst+(slot)))
  #define DMA_V(t,slot) glds16(vsrc+(long)(t)*KVBLK*PQ,(unsigned)__builtin_amdgcn_readfirstlane(vdst+(slot)))
  const int vb0=(int)(lds0+LDS_V)+((lane>>4)&1)*32+(lane&3)*8+(4*hi+((lane&15)>>2))*64;
  const char*Kbase=shm+LDS_K; bf16x8 kf[8];
  const lds_cptr shm3=(lds_cptr)shm; const lds_cptr kp0=shm3+LDS_K+hi*1024+r32*16; const lds_cptr vp0=shm3+LDS_V+((lane>>4)&1)*32+(lane&3)*8+(4*hi+((lane&15)>>2))*64;
  const int NT=(q0+QB)/KVBLK;
  DMA_K(0,0);DMA_V(0,0);DMA_K(1,SLOTB);
  bf16x8 qr[4];
  #pragma unroll
  for(int d0=0;d0<4;++d0)qr[d0]=*reinterpret_cast<const bf16x8*>(&Qw[(long)r32*PQ+d0*16+hi*8]);
  float mhat=0.f,l_reg=0.f;f32x16 o[2];o[0]=f32x16{};o[1]=f32x16{};f32x16 negm;
  #pragma unroll
  for(int r=0;r<16;++r)negm[r]=b31;
  asm volatile("":"+v"(negm));
  const int qrel=wid*QBLK+r32;
  #define CMASK(P0,P1,t) do{int dt_=(NT-4)-(t); if(dt_<=2)cmask(P0,P1,dt_,qrel,hi,tab);}while(0)
  bool resc=false;
  #define START(P0,P1) do{ const float rm=rowmax(P0,P1); resc=false; \
    { const float dl=rm; mhat=fadd_s(mhat,dl); \
      _Pragma("unroll") for(int r=0;r<16;++r){P0[r]=fsub_s(P0[r],dl);P1[r]=fsub_s(P1[r],dl);} \
      _Pragma("unroll") for(int r=0;r<16;++r)negm[r]=b31-mhat; asm volatile("":"+v"(negm)); } \
    _Pragma("unroll") for(int r=0;r<16;++r)P0[r]=__builtin_amdgcn_exp2f(P0[r]); }while(0)
  #define RESC() do{ if(resc){ asm volatile("s_waitcnt lgkmcnt(0)":::"memory"); \
      _Pragma("unroll") for(int d_=0;d_<2;++d_) _Pragma("unroll") for(int r=0;r<16;++r)o[d_][r]*=wsf[crow(r,hi)]; } }while(0)
  f32x16 pA0,pA1,pB0,pB1;
  int sl_prev=0,sl_cur=0,sl_next=SLOTB;
  #define ROT() do{sl_prev=sl_cur;sl_cur=sl_next;sl_next=(sl_next==(NSLOT-1)*SLOTB)?0:sl_next+SLOTB;}while(0)
  DMA_K(2,2*SLOTB);
  WAIT_BAR(3);
  qkt(pA0,pA1,Kbase,qr,negm,r32,hi);asm volatile("s_nop 15\n\ts_nop 7":"+v"(pA0),"+v"(pA1));CMASK(pA0,pA1,0);
  START(pA0,pA1);
  _Pragma("unroll") for(int r=0;r<16;++r)pA1[r]=__builtin_amdgcn_exp2f(pA1[r]);
  WAIT_BAR(0);
  DMA_K(3,0);DMA_V(1,SLOTB);
  ROT();
  kload8(kf,kp0+sl_cur);
  WAIT_BAR(2);
  s16x4 vlo[8],vhi[8]; u32x4 pw0,pw1,pw2,pw3;
  #define PKW(P,B) cvtpk_s(P[B],P[B+1])
  #define PAF(k) __builtin_bit_cast(bf16x8,pw##k)
  #define VFR(i) (bf16x8){vlo[i][0],vlo[i][1],vlo[i][2],vlo[i][3],vhi[i][0],vhi[i][1],vhi[i][2],vhi[i][3]}
  #define PIN(x) asm volatile("":"+v"(x))
  #define MX3(a,b,c) __builtin_fmaxf(__builtin_fmaxf((a),(b)),(c))
  #define GAPA(MF,A0,A1,A2,A3,W0,W1,PW) do{ MF; sacc+=A0; sacc+=A1; sacc+=A2; sacc+=A3; PIN(sacc); W0; W1; PIN(PW); SBAR(); }while(0)
  #define EX(v) __builtin_amdgcn_exp2f(v)
  #define GAPB(MF,X,B) do{ MF; X[B]=EX(X[B]); X[B+1]=EX(X[B+1]); X[B+2]=EX(X[B+2]); X[B+3]=EX(X[B+3]); PIN(X); SBAR(); }while(0)
  #define VRD(i) do{ vlo[i]=vtr(vp_+(((i)>>2)*4096+((i)&3)*1024)); vhi[i]=vtr(vp_+(((i)>>2)*4096+((i)&3)*1024+512)); }while(0)
  #define KRD(G,j) do{ if(G){ kload2(kf,kp0+sl_next,j); SBAR(); } }while(0)
  #define STEP(C0,C1,P0,P1,t,GK,GV,GL) do{ SBAR(); \
    const lds_cptr vp_=vp0+sl_prev; \
    VRD(0); SBAR(); float sacc=(P0[0]+P0[1]); \
    GAPA(C0=__builtin_amdgcn_mfma_f32_32x32x16_bf16(kf[0],qr[0],negm,0,0,0), P0[2],P0[3],P0[4],P0[5],     pw0[0]=PKW(P0,0), pw0[1]=PKW(P0,2), pw0); \
    VRD(4); SBAR(); GAPA(C1=__builtin_amdgcn_mfma_f32_32x32x16_bf16(kf[1],qr[0],negm,0,0,0), P0[6],P0[7],P0[8],P0[9],     pw0[2]=PKW(P0,4), pw0[3]=PKW(P0,6), pw0); \
    VRD(1); SBAR(); GAPA(C0=__builtin_amdgcn_mfma_f32_32x32x16_bf16(kf[2],qr[1],C0,0,0,0),   P0[10],P0[11],P0[12],P0[13], pw1[0]=PKW(P0,8), pw1[1]=PKW(P0,10), pw1); \
    VRD(5); SBAR(); GAPA(C1=__builtin_amdgcn_mfma_f32_32x32x16_bf16(kf[3],qr[1],C1,0,0,0),   P0[14],P0[15],P1[0],P1[1],   pw1[2]=PKW(P0,12),pw1[3]=PKW(P0,14), pw1); \
    VRD(2); SBAR(); GAPA(C0=__builtin_amdgcn_mfma_f32_32x32x16_bf16(kf[4],qr[2],C0,0,0,0),   P1[2],P1[3],P1[4],P1[5],     pw2[0]=PKW(P1,0), pw2[1]=PKW(P1,2), pw2); \
    VRD(6); SBAR(); GAPA(C1=__builtin_amdgcn_mfma_f32_32x32x16_bf16(kf[5],qr[2],C1,0,0,0),   P1[6],P1[7],P1[8],P1[9],     pw2[2]=PKW(P1,4), pw2[3]=PKW(P1,6), pw2); \
    VRD(3); SBAR(); GAPA(C0=__builtin_amdgcn_mfma_f32_32x32x16_bf16(kf[6],qr[3],C0,0,0,0),   P1[10],P1[11],P1[12],P1[13], pw3[0]=PKW(P1,8), pw3[1]=PKW(P1,10), pw3); \
    VRD(7); SBAR(); GAPA(C1=__builtin_amdgcn_mfma_f32_32x32x16_bf16(kf[7],qr[3],C1,0,0,0),   P1[14],P1[15],0.f,0.f,       pw3[2]=PKW(P1,12),pw3[3]=PKW(P1,14), pw3); \
    l_reg+=sacc; \
    if(GK){DMA_K((t)+3,sl_cur);} if(GV){DMA_V((t)+1,sl_next);} \
    CMASK(C0,C1,t); \
    { float a=MX3(C0[0],C0[1],C1[0]),b=MX3(C0[2],C0[3],C1[1]); a=MX3(a,C1[2],C1[3]); \
      _Pragma("unroll") for(int r=4;r<16;r+=4){a=MX3(a,C0[r],C0[r+1]);b=MX3(b,C0[r+2],C0[r+3]);a=MX3(a,C1[r],C1[r+1]);b=MX3(b,C1[r+2],C1[r+3]);} \
      float rm=__builtin_fmaxf(a,b); { auto rr=__builtin_amdgcn_permlane32_swap(__float_as_uint(rm),__float_as_uint(rm),false,false); rm=__builtin_fmaxf(__uint_as_float(rr[0]),__uint_as_float(rr[1])); } \
      resc=false; \
      if(__builtin_expect(__any(rm>(float)THRL),0)){ const float dl=__builtin_fmaxf(rm,0.f); mhat+=dl; \
        _Pragma("unroll") for(int r=0;r<16;++r){C0[r]-=dl;C1[r]-=dl;} \
        _Pragma("unroll") for(int r=0;r<16;++r)negm[r]=b31-mhat; asm volatile("":"+v"(negm)); \
        const float f=__builtin_amdgcn_exp2f(-dl); l_reg*=f; if(hi==0)wsf[r32]=f; resc=true; } } \
    SBAR(); \
    GAPB(o[0]=__builtin_amdgcn_mfma_f32_32x32x16_bf16(PAF(0),VFR(0),o[0],0,0,0), C0,0); \
    GAPB(o[1]=__builtin_amdgcn_mfma_f32_32x32x16_bf16(PAF(0),VFR(4),o[1],0,0,0), C0,4); \
    KRD(GL,0); GAPB(o[0]=__builtin_amdgcn_mfma_f32_32x32x16_bf16(PAF(1),VFR(1),o[0],0,0,0), C0,8); \
    KRD(GL,1); GAPB(o[1]=__builtin_amdgcn_mfma_f32_32x32x16_bf16(PAF(1),VFR(5),o[1],0,0,0), C0,12); \
    KRD(GL,2); GAPB(o[0]=__builtin_amdgcn_mfma_f32_32x32x16_bf16(PAF(2),VFR(2),o[0],0,0,0), C1,0); \
    KRD(GL,3); GAPB(o[1]=__builtin_amdgcn_mfma_f32_32x32x16_bf16(PAF(2),VFR(6),o[1],0,0,0), C1,4); \
    GAPB(o[0]=__builtin_amdgcn_mfma_f32_32x32x16_bf16(PAF(3),VFR(3),o[0],0,0,0), C1,8); \
    GAPB(o[1]=__builtin_amdgcn_mfma_f32_32x32x16_bf16(PAF(3),VFR(7),o[1],0,0,0), C1,12); \
    }while(0)
  int t=1;
  #undef CMASK
  #define CMASK(P0,P1,t) do{}while(0)
  for(;t+7<NT;t+=2){
    STEP(pB0,pB1,pA0,pA1,t,true,true,true);     WAIT_BAR(2); RESC(); ROT();
    STEP(pA0,pA1,pB0,pB1,t+1,true,true,true);   WAIT_BAR(2); RESC(); ROT();
  }
  #undef CMASK
  #define CMASK(P0,P1,t) do{int dt_=(NT-4)-(t); if(dt_<=2)cmask(P0,P1,dt_,qrel,hi,tab);}while(0)
  #define ENDW(tt) do{ if((tt)+3<NT){WAIT_BAR(2);} else if((tt)+2<NT){WAIT_BAR(1);} else {WAIT_BAR(0);} }while(0)
  for(;t+1<NT;t+=2){
    STEP(pB0,pB1,pA0,pA1,t,(t+3<NT),(t+1<NT),(t+1<NT));       ENDW(t);   RESC(); ROT();
    STEP(pA0,pA1,pB0,pB1,t+1,(t+4<NT),(t+2<NT),(t+2<NT));     ENDW(t+1); RESC(); ROT();
  }
  STEP(pB0,pB1,pA0,pA1,NT-1,false,false,false); RESC();
  { float sacc=pB0[0]+pB0[1]; _Pragma("unroll") for(int r=2;r<16;++r)sacc+=pB0[r]; _Pragma("unroll") for(int r=0;r<16;++r)sacc+=pB1[r]; l_reg+=sacc;
    pw0=(u32x4){PKW(pB0,0),PKW(pB0,2),PKW(pB0,4),PKW(pB0,6)};pw1=(u32x4){PKW(pB0,8),PKW(pB0,10),PKW(pB0,12),PKW(pB0,14)};pw2=(u32x4){PKW(pB1,0),PKW(pB1,2),PKW(pB1,4),PKW(pB1,6)};pw3=(u32x4){PKW(pB1,8),PKW(pB1,10),PKW(pB1,12),PKW(pB1,14)};
    SBAR(); pv(o,vb0+sl_cur,PAF(0),PAF(1),PAF(2),PAF(3)); }
  #undef PKW
  #undef PAF
  #undef VFR
  #undef PIN
  #undef MX3
  #undef GAPA
  #undef GAPB
  #undef EX
  #undef VRD
  #undef KRD
  #undef STEP
  #undef ENDW
  {auto rr=__builtin_amdgcn_permlane32_swap(__float_as_uint(l_reg),__float_as_uint(l_reg),false,false);l_reg=__uint_as_float(rr[0])+__uint_as_float(rr[1]);}
  if(hi==0)wsf[32+r32]=l_reg;asm volatile("s_waitcnt lgkmcnt(0)":::"memory");
  float rli[16];
  #pragma unroll
  for(int r=0;r<16;++r)rli[r]=__builtin_amdgcn_rcpf(wsf[32+crow(r,hi)]);
  bf16*Ow=O+(rowbase+q0+wid*QBLK)*DM+vh*D;
  { bf16*stg=(bf16*)(shm+LDS_OST)+wid*2048;
    #pragma unroll
    for(int r=0;r<16;++r){const int orow=crow(r,hi);
      #pragma unroll
      for(int d0=0;d0<2;++d0)stg[orow*64+d0*32+r32]=__float2bfloat16(o[d0][r]*rli[r]);}
    asm volatile("s_waitcnt lgkmcnt(0)":::"memory");
    #pragma unroll
    for(int i=0;i<4;++i){const int row=i*8+(lane>>3),ch=lane&7; const u32x4 v=*(const u32x4*)(stg+row*64+ch*8); ATTN_STORE16(Ow+(long)row*DM+ch*8,v);} }
  asm volatile("s_waitcnt lgkmcnt(0)\n\ts_barrier":::"memory");
  #undef DMA_K
  #undef DMA_V
  #undef CMASK
  #undef START
  #undef RESC
  #undef ROT
}
constexpr int ATTN_LDS_BYTES=LDS_BYTES;
struct AttnTensors { const bf16* QKV; bf16* O; lds_fptr tabs; lds_fptr b31; };
struct AttnUnit { int bh; int qb; };
struct StaticOrder {
  int vcu,G;
  __device__ __forceinline__ StaticOrder(int grid,int v):vcu(v),G(grid){}
  __device__ __forceinline__ bool next(int i,AttnUnit&u)const{ const int pr=vcu+(i>>4)*G; if(pr>=BATCH*NHEAD)return false; u.bh=pr; u.qb=15-(i&15); return true; }
};
template<class Sched,int THRL=8> __device__ __forceinline__ void attn_phase(char*lds,const AttnTensors&T,const Sched&S){
  AttnUnit u;
  for(int i=0;S.next(i,u);++i){ const int vh=u.bh%NHEAD; attn_unit<THRL>(u.bh/NHEAD,vh,u.qb,T.QKV,T.O,lds,T.tabs+(vh>>2)*TABN,T.b31[vh>>2]); }
}
#undef SBAR
#undef WAIT_BAR
}


constexpr int NWAVES = 8;
constexpr int BATCH = 16, SEQ = 4096, D = 1024, T = BATCH * SEQ;
constexpr int NPH = 15;
constexpr float NORM_EPS = 1e-6f, SUBLN_EPS = 1e-5f, LAMBDA_INIT = 0.2f, LOG2E = 1.4426950408889634f;

constexpr size_t MiB = 1u << 20;
constexpr size_t WS_CTL = 0, CTL_ZERO_BYTES = 2 * MiB;
constexpr size_t WS_MOD = 1 * MiB;
constexpr size_t WS_TAB = 2 * MiB;
constexpr size_t TAB_BBT = 0, TAB_CCT = 128 * 1024, TAB_A = 256 * 1024, TAB_AL = 272 * 1024, TAB_BIAS = 288 * 1024, TAB_B31 = 300 * 1024, TAB_LAM = 300 * 1024 + 64;
constexpr size_t WS_WIN = 4 * MiB, WS_WGLU = 12 * MiB, WS_WPA = 13 * MiB, WS_WPS = 14 * MiB, WS_WOUT = 15 * MiB, WS_WR = 17 * MiB, WS_WE1 = 18 * MiB, WS_WE2 = 82 * MiB;
constexpr size_t WS_QKVU = 128 * MiB, WS_GATES = 384 * MiB, WS_H1 = 640 * MiB, WS_OV = 640 * MiB, WS_TMP = 640 * MiB, WS_YATTN = 768 * MiB, WS_YSSM = 832 * MiB, WS_S = 896 * MiB,
                 WS_SSMEND = 960 * MiB, WS_MERGED = 128 * MiB, WS_X1 = 384 * MiB, WS_H2 = 896 * MiB, WS_LOGITS = 264 * MiB, WS_LIST = 280 * MiB, WS_TOK = 288 * MiB, WS_ACT = 128 * MiB, WS_YS = 640 * MiB,
                 WS_END = 1024 * MiB;
constexpr int CW_TMO = 0, CW_CODE = 1, CW_BAR = 4096, CW_CNT = 8192;

constexpr int RING_OFF = 0, RING_BYTES = 131072;
constexpr int LDSCTL_OFF = RING_BYTES, MISC_OFF = LDSCTL_OFF + 320;
constexpr int TBL_OFF = LDSCTL_OFF + 512;
constexpr int TBL_TILE_E = TBL_OFF, TBL_TSTART = TBL_OFF + 2304, TBL_CNT = TBL_TSTART + 256, TBL_ROWTAB = TBL_CNT + 128, ROWTAB_UNITS = 10;
constexpr int LDS_BYTES = 147456;
static_assert(TBL_ROWTAB + ROWTAB_UNITS * 1024 <= LDS_BYTES, "LDS map");
constexpr int ATT_TAB_OFF = 86016;

#define GAS __attribute__((address_space(1)))
#define LAS __attribute__((address_space(3)))
typedef unsigned short bf16;
typedef unsigned v4u __attribute__((ext_vector_type(4)));
typedef float f32x4 __attribute__((ext_vector_type(4)));
typedef short bf16x8 __attribute__((ext_vector_type(8)));
typedef GAS unsigned gu32;
typedef GAS unsigned long long gu64;
#define RLX_AGENT __ATOMIC_RELAXED, __HIP_MEMORY_SCOPE_AGENT
#define LDS_WAIT() asm volatile("s_waitcnt lgkmcnt(0)" ::: "memory")
#define VM_WAIT() asm volatile("s_waitcnt vmcnt(0)" ::: "memory")
__device__ __forceinline__ unsigned long long rt() { return __builtin_amdgcn_s_memrealtime(); }
__device__ __forceinline__ unsigned f2bf(float f) { unsigned u = __builtin_bit_cast(unsigned, f); return (u + 0x7fffu + ((u >> 16) & 1u)) >> 16; }
__device__ __forceinline__ unsigned pk2(float lo, float hi) { return f2bf(lo) | (f2bf(hi) << 16); }

#define XB_TMO      128
#define XB_XCNT(j)  (256  + 64 * (j))
#define XB_XSUB(j)  (1280 + 64 * (j))
#define XB_XGEN(j)  (2304 + 64 * (j))
#define XB_TOP      3328
#define XB_TOPGEN   3392
#define XCD_BAR_WORDS 3456
#define XB_SPIN_CAP (1u << 18)

__device__ __forceinline__ unsigned xb_ld(unsigned* p)              { return __hip_atomic_load(p, __ATOMIC_RELAXED, __HIP_MEMORY_SCOPE_AGENT); }
__device__ __forceinline__ unsigned xb_add(unsigned* p, unsigned v) { return __hip_atomic_fetch_add(p, v, __ATOMIC_RELAXED, __HIP_MEMORY_SCOPE_AGENT); }
__device__ __forceinline__ unsigned xb_xcc_id() { return (unsigned)__builtin_amdgcn_s_getreg((3 << 11) | 20) & 0xFu; }
#define XB_SPIN(cond, bar) do { unsigned _sp = 0; while (cond) { __builtin_amdgcn_s_sleep(1); \
    if ((++_sp & 255u) == 0u) { if (xb_ld(&(bar)[XB_TMO])) break; if (_sp > XB_SPIN_CAP) { atomicAdd(&(bar)[XB_TMO], 1u); break; } } } } while (0)

struct XcdBarrier {
    unsigned* bar; unsigned x;
    volatile LAS unsigned* st;
};

__device__ __forceinline__ XcdBarrier xcd_barrier_post(unsigned* bar, volatile LAS unsigned* st) {
    XcdBarrier b; b.bar = bar; b.x = xb_xcc_id(); b.st = st;
    if (threadIdx.x == 0) (void)xb_add(&bar[XB_XCNT(b.x)], 1u);
    return b;
}
__device__ __forceinline__ void xcd_barrier_complete(unsigned* bar, unsigned x, unsigned& nloc, unsigned& nx) {
    const unsigned G = gridDim.x * gridDim.y * gridDim.z;
    unsigned sum, cnt, mine, sp = 0u;
    for (;;) {
        sum = 0u; cnt = 0u; mine = 0u;
#pragma unroll
        for (unsigned j = 0; j < 16; ++j) { const unsigned c = xb_ld(&bar[XB_XCNT(j)]); sum += c; cnt += (c > 0u) ? 1u : 0u; mine = (j == x) ? c : mine; }
        if (sum == G) break;
        __builtin_amdgcn_s_sleep(1);
        if ((++sp & 255u) == 0u) { if (xb_ld(&bar[XB_TMO])) break; if (sp > XB_SPIN_CAP) { atomicAdd(&bar[XB_TMO], 1u); break; } }
    }
    nloc = mine > 0u ? mine : 1u; nx = cnt > 0u ? cnt : 1u;
}

__device__ __forceinline__ void xcd_barrier(const XcdBarrier& b) {
    asm volatile("s_waitcnt vmcnt(0)" ::: "memory");
    __syncthreads();
    if (threadIdx.x == 0) {
        unsigned* bar = b.bar;
        __builtin_amdgcn_s_waitcnt(0);
        unsigned nloc = b.st[0], nx = b.st[1];
        if (nloc == 0u) { xcd_barrier_complete(bar, b.x, nloc, nx); b.st[0] = nloc; b.st[1] = nx; }
        const unsigned old = xb_add(&bar[XB_XSUB(b.x)], 1u);
        const unsigned gen = old / nloc;
        if (old + 1u == (gen + 1u) * nloc) {
            __builtin_amdgcn_fence(__ATOMIC_RELEASE, "agent");
            asm volatile("s_waitcnt vmcnt(0)" ::: "memory");
            const unsigned og = xb_add(&bar[XB_TOP], 1u);
            const unsigned tg = og / nx;
            if (og + 1u == (tg + 1u) * nx) xb_add(&bar[XB_TOPGEN], 1u);
            else XB_SPIN(xb_ld(&bar[XB_TOPGEN]) == tg, bar);
            __builtin_amdgcn_fence(__ATOMIC_ACQUIRE, "agent");
            xb_add(&bar[XB_XGEN(b.x)], 1u);
            asm volatile("s_waitcnt vmcnt(0)" ::: "memory");
        } else {
            XB_SPIN(xb_ld(&bar[XB_XGEN(b.x)]) == gen, bar);
            __builtin_amdgcn_fence(__ATOMIC_ACQUIRE, "agent");
            asm volatile("s_waitcnt vmcnt(0)" ::: "memory");
        }
    }
    __syncthreads();
}


struct Frame {
    LAS unsigned char* lds;
    volatile LAS unsigned* MISC;
    gu32* ctl;
    int tid, lane, wave;
    int vcu, G;
    const float* in[32]; float* out; unsigned char* ws;
};
#define WSP(T_, off) ((T_*)(F.ws + (off)))
__device__ __forceinline__ float wave_sum(float v) {
#pragma unroll
    for (int o = 1; o < 64; o <<= 1) v += __shfl_xor(v, o);
    return v;
}
__device__ __forceinline__ float bflo(unsigned w) { return __uint_as_float(w << 16); }
__device__ __forceinline__ float bfhi(unsigned w) { return __uint_as_float(w & 0xffff0000u); }
__device__ __forceinline__ float sigm_(float x) { return __builtin_amdgcn_rcpf(1.f + __builtin_amdgcn_exp2f(-LOG2E * x)); }

__device__ __forceinline__ void p0_transpose_item(const float* W, int K, int N, bf16* WT, int permHalf, LAS float* scr, int item, int lane) {
    const int nblk = N / 32, kb = item / nblk, nb = item % nblk, k0 = 64 * kb, n0 = 32 * nb;
    float tv[32];
#pragma unroll
    for (int i = 0; i < 32; ++i) tv[i] = W[(size_t)(k0 + 2 * i + (lane >> 5)) * N + n0 + (lane & 31)];
#pragma unroll
    for (int i = 0; i < 32; ++i) scr[(2 * i + (lane >> 5)) * 33 + (lane & 31)] = tv[i];
    LDS_WAIT(); asm volatile("" ::: "memory");
    const int c = lane & 7;
    int r0 = n0; if (permHalf) { const int bj = n0 / permHalf, idx = n0 % permHalf; r0 = 256 * (idx / 128) + 128 * bj + (idx % 128); }
#pragma unroll
    for (int j = 0; j < 4; ++j) { const int n = (lane >> 3) + 8 * j; const LAS float* s = scr + (8 * c) * 33 + n;
        v4u o; o.x = pk2(s[0 * 33], s[1 * 33]); o.y = pk2(s[2 * 33], s[3 * 33]); o.z = pk2(s[4 * 33], s[5 * 33]); o.w = pk2(s[6 * 33], s[7 * 33]);
        *(GAS v4u*)(WT + (size_t)(r0 + n) * K + k0 + 8 * c) = o; }
    LDS_WAIT(); asm volatile("" ::: "memory");
}
__device__ __forceinline__ void p0_prologue(Frame& F) {
    LAS float* scr = (LAS float*)(F.lds + RING_OFF + F.wave * 16384);
    const int gw = F.vcu * NWAVES + F.wave, NGW = F.G * NWAVES, lane = F.lane;
    constexpr int I_IN = 16 * 128, I_GLU = 8 * 32, I_PA = 8 * 32, I_PS = 8 * 32, I_OUT = 16 * 32, I_E1 = 32 * 512, I_E2 = 32 * 256, I_R = 256, I_SSM = 32, I_MISC = 1;
    constexpr int NITEMS = I_IN + I_GLU + I_PA + I_PS + I_OUT + I_E1 + I_E2 + I_R + I_SSM + I_MISC;
    for (int cb = F.vcu; cb < 96; cb += F.G) {
        const int j = cb * 64 + lane, k0 = F.wave * 128; const float* c = F.in[1]; const float* wa = F.in[2];
#pragma unroll
        for (int q = 0; q < 32; ++q) { const int idx = q * 64 + lane, kk = idx >> 4, b = idx & 15; const float v = c[b * 1024 + k0 + kk]; scr[idx] = v * sigm_(v); }
        LDS_WAIT(); asm volatile("" ::: "memory");
        float acc[16];
#pragma unroll
        for (int b = 0; b < 16; ++b) acc[b] = 0.f;
#pragma unroll 8
        for (int kk = 0; kk < 128; ++kk) { const float w = wa[(size_t)(k0 + kk) * 6144 + j];
#pragma unroll
            for (int q = 0; q < 4; ++q) { const f32x4 cv = *(const LAS f32x4*)(scr + kk * 16 + 4 * q); acc[4 * q] += w * cv.x; acc[4 * q + 1] += w * cv.y; acc[4 * q + 2] += w * cv.z; acc[4 * q + 3] += w * cv.w; } }
#pragma unroll
        for (int b = 0; b < 16; ++b) scr[2048 + b * 64 + lane] = acc[b];
        __syncthreads();
        float* mod = WSP(float, WS_MOD);
#pragma unroll
        for (int bb = 0; bb < 2; ++bb) { const int b = F.wave + 8 * bb; float sum = F.in[3][j];
#pragma unroll
            for (int w2 = 0; w2 < 8; ++w2) sum += ((const LAS float*)(F.lds + RING_OFF + w2 * 16384))[2048 + b * 64 + lane];
            mod[b * 6144 + j] = sum; }
        __syncthreads();
    }
    for (int it = gw; it < NITEMS; it += NGW) {
        int r = it;
        if (r < I_IN) { p0_transpose_item(F.in[5], 1024, 4096, WSP(bf16, WS_WIN), 0, scr, r, lane); continue; } r -= I_IN;
        if (r < I_GLU) { p0_transpose_item(F.in[20], 512, 1024, WSP(bf16, WS_WGLU), 512, scr, r, lane); continue; } r -= I_GLU;
        if (r < I_PA) { p0_transpose_item(F.in[21], 512, 1024, WSP(bf16, WS_WPA), 0, scr, r, lane); continue; } r -= I_PA;
        if (r < I_PS) { p0_transpose_item(F.in[22], 512, 1024, WSP(bf16, WS_WPS), 0, scr, r, lane); continue; } r -= I_PS;
        if (r < I_OUT) { p0_transpose_item(F.in[23], 1024, 1024, WSP(bf16, WS_WOUT), 0, scr, r, lane); continue; } r -= I_OUT;
        if (r < I_E1) { const int e = r / 512; p0_transpose_item(F.in[29] + (size_t)e * 1024 * 1024, 1024, 1024, WSP(bf16, WS_WE1) + (size_t)e * 1024 * 1024, 512, scr, r % 512, lane); continue; } r -= I_E1;
        if (r < I_E2) { const int e = r / 256; p0_transpose_item(F.in[30] + (size_t)e * 512 * 1024, 512, 1024, WSP(bf16, WS_WE2) + (size_t)e * 1024 * 512, 0, scr, r % 256, lane); continue; } r -= I_E2;
        if (r < I_R) {
            const int n = r; bf16* dst = WSP(bf16, WS_WR) + (size_t)n * 1024;
            for (int k = lane; k < 1024; k += 64) { float v = 0.f;
                if (n < 4) v = F.in[25][k * 4 + n]; else if (n < 36) { const int gq = (n - 4) >> 3, e = (n - 4) & 7; v = F.in[27][((size_t)gq * 1024 + k) * 8 + e]; }
                dst[k] = (bf16)f2bf(v); }
            continue; } r -= I_R;
        if (r < I_SSM) {
            const int g = r, p = lane;
            const float lr = fminf(F.in[12][g * 64 + p], -1e-4f), li = F.in[13][g * 64 + p], step = expf(F.in[14][g]);
            const float mag = expf(lr * step), ang = li * step, a_re = mag * cosf(ang), a_im = mag * sinf(ang);
            const float den = lr * lr + li * li, num_re = a_re - 1.0f, coef_re = (num_re * lr + a_im * li) / den, coef_im = (a_im * lr - num_re * li) / den;
            float* At = WSP(float, WS_TAB + TAB_A); float* AL = WSP(float, WS_TAB + TAB_AL);
            At[(g * 64 + p) * 2] = a_re; At[(g * 64 + p) * 2 + 1] = a_im;
            float zr = a_re, zi = a_im;
#pragma unroll
            for (int s = 0; s < 8; ++s) { const float nr = zr * zr - zi * zi, ni = 2.f * zr * zi; zr = nr; zi = ni; }
            AL[(g * 64 + p) * 2] = zr; AL[(g * 64 + p) * 2 + 1] = zi;
            bf16* BBt = WSP(bf16, WS_TAB + TAB_BBT); bf16* CCt = WSP(bf16, WS_TAB + TAB_CCT);
            const int n_re = ((p < 32) ? 0 : 64) + (p & 31), n_im = n_re + 32;
            for (int h = 0; h < 16; ++h) { const float br = F.in[15][(g * 64 + p) * 16 + h], bi = F.in[16][(g * 64 + p) * 16 + h];
                BBt[(g * 128 + n_re) * 16 + h] = (bf16)f2bf(coef_re * br - coef_im * bi); BBt[(g * 128 + n_im) * 16 + h] = (bf16)f2bf(coef_re * bi + coef_im * br);
                CCt[(g * 16 + h) * 128 + 2 * p] = (bf16)f2bf(F.in[17][(g * 16 + h) * 64 + p]); CCt[(g * 16 + h) * 128 + 2 * p + 1] = (bf16)f2bf(-F.in[18][(g * 16 + h) * 64 + p]); }
            continue; } r -= I_SSM;
        {
            float* tb = WSP(float, WS_TAB + TAB_BIAS); float* b31 = WSP(float, WS_TAB + TAB_B31); float* lamp = WSP(float, WS_TAB + TAB_LAM);
            const float* rb = F.in[6];
            for (int idx = lane; idx < 4 * attn_body::TABN; idx += 64) { const int h = idx / attn_body::TABN, d = idx % attn_body::TABN - 255; float v = 0.f;
                if (d < 0) v = -INFINITY;
                else if (d < 128) { int bk;
                    if (d < 16) bk = d; else { const float lr = logf((float)d / 16.f) / logf(8.f); bk = 16 + (int)(lr * 16.f); bk = bk > 31 ? 31 : bk; }
                    v = (rb[bk * 4 + h] - rb[31 * 4 + h]) * LOG2E; }
                tb[idx] = v; }
            if (lane < 4) b31[lane] = rb[31 * 4 + lane] * LOG2E;
            const float s1 = wave_sum(F.in[7][lane] * F.in[8][lane]), s2 = wave_sum(F.in[9][lane] * F.in[10][lane]);
            if (lane == 0) lamp[0] = expf(s1) - expf(s2) + LAMBDA_INIT;
        }
    }
}

template <bool XBF> __device__ __forceinline__ void ln_load_row(int lane, const void* xrow, f32x4 (&v)[4]) {
    if (XBF) { const GAS unsigned long long* xr = (const GAS unsigned long long*)xrow + lane;
#pragma unroll
        for (int j = 0; j < 4; ++j) { const unsigned long long w = xr[64 * j]; v[j].x = bflo((unsigned)w); v[j].y = bfhi((unsigned)w); v[j].z = bflo((unsigned)(w >> 32)); v[j].w = bfhi((unsigned)(w >> 32)); } }
    else { const GAS f32x4* xr = (const GAS f32x4*)xrow + lane;
#pragma unroll
        for (int j = 0; j < 4; ++j) v[j] = xr[64 * j]; }
}
__device__ __forceinline__ void ln_store_row(int lane, const f32x4 (&v)[4], const float* gv, const float* shift, const float* scale, bf16* orow) {
    float s = 0.f;
#pragma unroll
    for (int j = 0; j < 4; ++j) s += (v[j].x * v[j].x + v[j].y * v[j].y) + (v[j].z * v[j].z + v[j].w * v[j].w);
    const float rstd = 1.f / sqrtf(wave_sum(s) * (1.f / D) + NORM_EPS);
    GAS unsigned long long* o8 = (GAS unsigned long long*)orow + lane;
#pragma unroll
    for (int j = 0; j < 4; ++j) { const f32x4 g4 = ((const f32x4*)gv)[lane + 64 * j], sh = ((const f32x4*)shift)[lane + 64 * j], sc = ((const f32x4*)scale)[lane + 64 * j];
        const f32x4 h = v[j] * rstd * g4 * (sc + 1.f) + sh;
        o8[64 * j] = (unsigned long long)pk2(h.x, h.y) | ((unsigned long long)pk2(h.z, h.w) << 32); }
}
template <bool XBF> __device__ __forceinline__ void ln_phase(Frame& F, const void* x, const float* gv, int shift_off, int scale_off, bf16* out) {
    const int gw = F.vcu * NWAVES + F.wave, NGW = F.G * NWAVES; const float* mod = WSP(float, WS_MOD); const size_t xpitch = XBF ? (size_t)D * 2 : (size_t)D * 4;
    for (int m = gw; m < T; m += 2 * NGW) { const int m2 = m + NGW; f32x4 v0[4], v1[4];
        ln_load_row<XBF>(F.lane, (const char*)x + (size_t)m * xpitch, v0); if (m2 < T) ln_load_row<XBF>(F.lane, (const char*)x + (size_t)m2 * xpitch, v1);
        { const float* mb = mod + (size_t)(m >> 12) * 6144; ln_store_row(F.lane, v0, gv, mb + shift_off, mb + scale_off, out + (size_t)m * D); }
        if (m2 < T) { const float* mb = mod + (size_t)(m2 >> 12) * 6144; ln_store_row(F.lane, v1, gv, mb + shift_off, mb + scale_off, out + (size_t)m2 * D); } }
}
__device__ __forceinline__ void attn_combine_phase(Frame& F) {
    const int gw = F.vcu * NWAVES + F.wave, NGW = F.G * NWAVES, lane = F.lane;
    const bf16* Ov = WSP(bf16, WS_OV); bf16* ya = WSP(bf16, WS_YATTN);
    const float lam = WSP(float, WS_TAB + TAB_LAM)[0];
    const int h = lane >> 4, half = (lane >> 3) & 1, d0 = 8 * (lane & 7);
    float gsub[8];
#pragma unroll
    for (int i = 0; i < 8; ++i) gsub[i] = F.in[11][half * 64 + d0 + i] * (1.f - LAMBDA_INIT);
    for (int m0 = gw; m0 < T; m0 += 4 * NGW) {
        v4u av[4], bv[4];
#pragma unroll
        for (int q = 0; q < 4; ++q) { const int m = m0 + q * NGW; if (m < T) { av[q] = *(const GAS v4u*)(Ov + (size_t)m * 1024 + (h * 4 + half) * 64 + d0); bv[q] = *(const GAS v4u*)(Ov + (size_t)m * 1024 + (h * 4 + 2 + half) * 64 + d0); } }
#pragma unroll
        for (int q = 0; q < 4; ++q) { const int m = m0 + q * NGW; if (m < T) { const v4u a = av[q], b = bv[q];
        float o[8];
        o[0] = bflo(a.x) - lam * bflo(b.x); o[1] = bfhi(a.x) - lam * bfhi(b.x); o[2] = bflo(a.y) - lam * bflo(b.y); o[3] = bfhi(a.y) - lam * bfhi(b.y);
        o[4] = bflo(a.z) - lam * bflo(b.z); o[5] = bfhi(a.z) - lam * bfhi(b.z); o[6] = bflo(a.w) - lam * bflo(b.w); o[7] = bfhi(a.w) - lam * bfhi(b.w);
        float ss = 0.f;
#pragma unroll
        for (int i = 0; i < 8; ++i) ss += o[i] * o[i];
        ss += __shfl_xor(ss, 1); ss += __shfl_xor(ss, 2); ss += __shfl_xor(ss, 4); ss += __shfl_xor(ss, 8);
        const float rs = 1.f / sqrtf(ss * (1.f / 128.f) + SUBLN_EPS);
        v4u w; w.x = pk2(o[0] * rs * gsub[0], o[1] * rs * gsub[1]); w.y = pk2(o[2] * rs * gsub[2], o[3] * rs * gsub[3]); w.z = pk2(o[4] * rs * gsub[4], o[5] * rs * gsub[5]); w.w = pk2(o[6] * rs * gsub[6], o[7] * rs * gsub[7]);
        *(GAS v4u*)(ya + (size_t)m * 512 + h * 128 + half * 64 + d0) = w; } }
    }
}

typedef float f32x16 __attribute__((ext_vector_type(16)));
template <int PASS> __device__ __forceinline__ void ssm_phase(Frame& F) {
    const int lane = F.lane, w = F.wave, q = lane & 31, hf = lane >> 5;
    LAS unsigned char* xl = F.lds + RING_OFF + w * 8704;
    const bf16* QKVU = WSP(bf16, WS_QKVU); bf16* YS = WSP(bf16, WS_YSSM); float* endp = WSP(float, WS_SSMEND);
    const bf16* BBt = WSP(bf16, WS_TAB + TAB_BBT); const bf16* CCt = WSP(bf16, WS_TAB + TAB_CCT); const float* At = WSP(float, WS_TAB + TAB_A); const float* AL = WSP(float, WS_TAB + TAB_AL);
    for (int unit = F.vcu; unit < 512; unit += F.G) {
        const int b = unit >> 5, cp = (unit >> 2) & 7, go = unit & 3, g = go * 8 + w, cc = cp + 8 * hf;
        bf16x8 Bf[4];
#pragma unroll
        for (int j = 0; j < 4; ++j) Bf[j] = *(const GAS bf16x8*)(BBt + (size_t)(g * 128 + j * 32 + q) * 16 + 8 * hf);
        const float ar0 = At[(g * 64 + q) * 2], ai0 = At[(g * 64 + q) * 2 + 1], ar1 = At[(g * 64 + 32 + q) * 2], ai1 = At[(g * 64 + 32 + q) * 2 + 1];
        float xr0 = 0.f, xi0 = 0.f, xr1 = 0.f, xi1 = 0.f;
        bf16x8 Cf[4]; float dsk[4];
        if (PASS == 2) {
            const float lr0 = AL[(g * 64 + q) * 2], li0 = AL[(g * 64 + q) * 2 + 1], lr1 = AL[(g * 64 + 32 + q) * 2], li1 = AL[(g * 64 + 32 + q) * 2 + 1];
            const float* eb = endp + (size_t)((b * 32 + g) * 16) * 128;
            for (int j = 0; j < 15; ++j) if (j < cc) {
                const float e0r = eb[j * 128 + q * 2], e0i = eb[j * 128 + q * 2 + 1], e1r = eb[j * 128 + (q + 32) * 2], e1i = eb[j * 128 + (q + 32) * 2 + 1];
                const float n0r = lr0 * xr0 - li0 * xi0 + e0r, n0i = lr0 * xi0 + li0 * xr0 + e0i, n1r = lr1 * xr1 - li1 * xi1 + e1r, n1i = lr1 * xi1 + li1 * xr1 + e1i;
                xr0 = n0r; xi0 = n0i; xr1 = n1r; xi1 = n1i; }
#pragma unroll
            for (int kk = 0; kk < 4; ++kk) Cf[kk] = *(const GAS bf16x8*)(CCt + (size_t)(g * 16 + (lane & 15)) * 128 + 32 * kk + 8 * (lane >> 4));
#pragma unroll
            for (int i = 0; i < 4; ++i) dsk[i] = F.in[19][g * 16 + 4 * (lane >> 4) + i];
        }
        const int cs = (q >> 2) & 1, lt = (q >> 3) * 4 + (q & 3);
        const bf16* up = QKVU + ((size_t)b * SEQ + (cp + 8 * cs) * 256 + lt) * 2048 + 1536 + g * 16 + 8 * hf;
        bf16x8 Af = *(const GAS bf16x8*)up;
        for (int sb = 0; sb < 16; ++sb) {
            bf16x8 An = Af; if (sb < 15) An = *(const GAS bf16x8*)(up + (size_t)(sb + 1) * 16 * 2048);
            f32x16 z;
#pragma unroll
            for (int i = 0; i < 16; ++i) z[i] = 0.f;
            const f32x16 c0 = __builtin_amdgcn_mfma_f32_32x32x16_bf16(Af, Bf[0], z, 0, 0, 0), c1 = __builtin_amdgcn_mfma_f32_32x32x16_bf16(Af, Bf[1], z, 0, 0, 0),
                         c2 = __builtin_amdgcn_mfma_f32_32x32x16_bf16(Af, Bf[2], z, 0, 0, 0), c3 = __builtin_amdgcn_mfma_f32_32x32x16_bf16(Af, Bf[3], z, 0, 0, 0);
#pragma unroll
            for (int i = 0; i < 16; ++i) {
                const float n0r = fmaf(-ai0, xi0, fmaf(ar0, xr0, c0[i])), n0i = fmaf(ai0, xr0, fmaf(ar0, xi0, c1[i]));
                const float n1r = fmaf(-ai1, xi1, fmaf(ar1, xr1, c2[i])), n1i = fmaf(ai1, xr1, fmaf(ar1, xi1, c3[i]));
                xr0 = n0r; xi0 = n0i; xr1 = n1r; xi1 = n1i;
                if (PASS == 2) { LAS unsigned* dst = (LAS unsigned*)(xl + (16 * hf + i) * 272 + q * 4); dst[0] = pg8::cvt_pk_bf16(xr0, xi0); dst[32] = pg8::cvt_pk_bf16(xr1, xi1); }
            }
            if (PASS == 2) {
                LDS_WAIT(); asm volatile("" ::: "memory");
#pragma unroll
                for (int mt = 0; mt < 2; ++mt) {
                    f32x4 ya = (f32x4){0.f, 0.f, 0.f, 0.f};
#pragma unroll
                    for (int kk = 0; kk < 4; ++kk) { const bf16x8 Xf = *(const LAS bf16x8*)(xl + ((lane & 15) + 16 * mt) * 272 + 64 * kk + 16 * (lane >> 4));
                        ya = __builtin_amdgcn_mfma_f32_16x16x32_bf16(Cf[kk], Xf, ya, 0, 0, 0); }
                    const size_t trow = (size_t)b * SEQ + (cp + 8 * mt) * 256 + sb * 16 + (lane & 15);
                    const unsigned long long uw = *(const GAS unsigned long long*)(QKVU + trow * 2048 + 1536 + g * 16 + 4 * (lane >> 4));
                    float y[4]; y[0] = ya[0] + dsk[0] * bflo((unsigned)uw); y[1] = ya[1] + dsk[1] * bfhi((unsigned)uw); y[2] = ya[2] + dsk[2] * bflo((unsigned)(uw >> 32)); y[3] = ya[3] + dsk[3] * bfhi((unsigned)(uw >> 32));
#pragma unroll
                    for (int i = 0; i < 4; ++i) { const float v = y[i]; y[i] = v * sigm_(1.5957691216057308f * (v + 0.044715f * v * v * v)); }
                    *(GAS unsigned long long*)(YS + trow * 512 + g * 16 + 4 * (lane >> 4)) = (unsigned long long)pk2(y[0], y[1]) | ((unsigned long long)pk2(y[2], y[3]) << 32);
                }
                LDS_WAIT(); asm volatile("" ::: "memory");
            }
            Af = An;
        }
        if (PASS == 1) { float* e = endp + (size_t)(((b * 32 + g) * 16 + cc)) * 128; e[q * 2] = xr0; e[q * 2 + 1] = xi0; e[(q + 32) * 2] = xr1; e[(q + 32) * 2 + 1] = xi1; }
    }
}

__device__ __forceinline__ void routing_phase(Frame& F) {
    LAS int* hist = (LAS int*)(F.lds + RING_OFF); LAS int* base = hist + 32;
    const float* logits = WSP(float, WS_LOGITS); int* list = WSP(int, WS_LIST); int* tok_e = WSP(int, WS_TOK); int* tok_r = tok_e + 2 * T; float* tok_w = (float*)(tok_r + 2 * T);
    const int tid = F.tid;
    for (int chunk = F.vcu; chunk < T / 256; chunk += F.G) {
        if (tid < 64) hist[tid] = 0;
        __syncthreads();
        int e1 = 0, e2 = 0, r1 = 0, r2 = 0; float w1 = 0.f, w2 = 0.f; const int tok = chunk * 256 + tid;
        if (tid < 256) {
            const float* lp = logits + (size_t)tok * 64;
            float lg[4]; { const f32x4 v = *(const f32x4*)lp; lg[0] = v.x + F.in[26][0]; lg[1] = v.y + F.in[26][1]; lg[2] = v.z + F.in[26][2]; lg[3] = v.w + F.in[26][3]; }
            int grp = 0; float mx = lg[0];
#pragma unroll
            for (int j = 1; j < 4; ++j) if (lg[j] > mx) { mx = lg[j]; grp = j; }
            float den = 0.f;
#pragma unroll
            for (int j = 0; j < 4; ++j) den += expf(lg[j] - mx);
            const float pg = 1.f / den;
            float le[8]; { const f32x4 a = *(const f32x4*)(lp + 4 + grp * 8), b = *(const f32x4*)(lp + 8 + grp * 8); const float* br = F.in[28] + grp * 8;
                le[0] = a.x + br[0]; le[1] = a.y + br[1]; le[2] = a.z + br[2]; le[3] = a.w + br[3]; le[4] = b.x + br[4]; le[5] = b.y + br[5]; le[6] = b.z + br[6]; le[7] = b.w + br[7]; }
            int i1 = 0; float v1 = le[0];
#pragma unroll
            for (int j = 1; j < 8; ++j) if (le[j] > v1) { v1 = le[j]; i1 = j; }
            int i2 = -1; float v2 = -INFINITY;
#pragma unroll
            for (int j = 0; j < 8; ++j) if (j != i1 && (i2 < 0 || le[j] > v2)) { v2 = le[j]; i2 = j; }
            const float ex = expf(v2 - v1), s1 = 1.f / (1.f + ex);
            w1 = pg * s1; w2 = pg * (ex * s1); e1 = grp * 8 + i1; e2 = grp * 8 + i2;
            r1 = __hip_atomic_fetch_add(&hist[e1], 1, __ATOMIC_RELAXED, __HIP_MEMORY_SCOPE_WORKGROUP); r2 = __hip_atomic_fetch_add(&hist[e2], 1, __ATOMIC_RELAXED, __HIP_MEMORY_SCOPE_WORKGROUP);
        }
        __syncthreads();
        if (tid < 32) base[tid] = (int)__hip_atomic_fetch_add((unsigned*)(F.ctl + CW_CNT) + tid, (unsigned)hist[tid], __ATOMIC_RELAXED, __HIP_MEMORY_SCOPE_AGENT);
        __syncthreads();
        if (tid < 256) { r1 += base[e1]; r2 += base[e2];
            list[(size_t)e1 * T + r1] = tok; list[(size_t)e2 * T + r2] = tok;
            tok_e[2 * tok] = e1; tok_e[2 * tok + 1] = e2; tok_r[2 * tok] = r1; tok_r[2 * tok + 1] = r2; tok_w[2 * tok] = w1; tok_w[2 * tok + 1] = w2; }
        __syncthreads();
    }
}
__device__ __forceinline__ int expert_tables(Frame& F) {
    LAS int* cnt = (LAS int*)(F.lds + TBL_CNT); LAS int* tstart = (LAS int*)(F.lds + TBL_TSTART); LAS int* tile_e = (LAS int*)(F.lds + TBL_TILE_E);
    if (F.tid < 32) cnt[F.tid] = (int)__hip_atomic_load((unsigned*)(F.ctl + CW_CNT) + F.tid, __ATOMIC_RELAXED, __HIP_MEMORY_SCOPE_AGENT);
    __syncthreads();
    if (F.tid == 0) { int s = 0; for (int e = 0; e < 32; ++e) { tstart[e] = s; s += (cnt[e] + 255) >> 8; } tstart[32] = s > 544 ? 544 : s; }
    __syncthreads();
    const int MT = tstart[32];
    for (int t = F.tid; t < MT; t += NWAVES * 64) { int e = 0; while (e < 31 && tstart[e + 1] <= t) ++e; tile_e[t] = e; }
    __syncthreads();
    return MT;
}
__device__ __forceinline__ void final_phase(Frame& F) {
    (void)expert_tables(F);
    const LAS int* tstart = (const LAS int*)(F.lds + TBL_TSTART);
    const int gw = F.vcu * NWAVES + F.wave, NGW = F.G * NWAVES, lane = F.lane;
    const bf16* x1 = WSP(bf16, WS_X1); const bf16* ys = WSP(bf16, WS_YS); const float* mod = WSP(float, WS_MOD);
    const int* tok_e = WSP(int, WS_TOK); const int* tok_r = tok_e + 2 * T; const float* tok_w = (const float*)(tok_r + 2 * T);
    for (int m0 = gw; m0 < T; m0 += 2 * NGW) {
        f32x4 v[2][4]; float ssq[2];
#pragma unroll
        for (int q = 0; q < 2; ++q) { const int m = m0 + q * NGW; ssq[q] = 0.f; if (m < T) {
            const int e0 = tok_e[2 * m], e1 = tok_e[2 * m + 1]; const size_t p0 = ((size_t)tstart[e0] << 8) + tok_r[2 * m], p1 = ((size_t)tstart[e1] << 8) + tok_r[2 * m + 1];
            const float w0 = tok_w[2 * m], w1 = tok_w[2 * m + 1];
            const GAS unsigned long long* xr = (const GAS unsigned long long*)(x1 + (size_t)m * D) + lane; const f32x4* g2 = (const f32x4*)(mod + (size_t)(m >> 12) * 6144 + 5120) + lane;
            const GAS unsigned long long* y0 = (const GAS unsigned long long*)(ys + p0 * 1024) + lane; const GAS unsigned long long* y1 = (const GAS unsigned long long*)(ys + p1 * 1024) + lane;
#pragma unroll
            for (int j = 0; j < 4; ++j) { const unsigned long long a = y0[64 * j], b = y1[64 * j], xw = xr[64 * j]; const f32x4 gt = g2[64 * j]; f32x4 mo, xv;
                mo.x = w0 * bflo((unsigned)a) + w1 * bflo((unsigned)b); mo.y = w0 * bfhi((unsigned)a) + w1 * bfhi((unsigned)b);
                mo.z = w0 * bflo((unsigned)(a >> 32)) + w1 * bflo((unsigned)(b >> 32)); mo.w = w0 * bfhi((unsigned)(a >> 32)) + w1 * bfhi((unsigned)(b >> 32));
                xv.x = bflo((unsigned)xw); xv.y = bfhi((unsigned)xw); xv.z = bflo((unsigned)(xw >> 32)); xv.w = bfhi((unsigned)(xw >> 32));
                v[q][j] = xv + gt * mo; ssq[q] += (v[q][j].x * v[q][j].x + v[q][j].y * v[q][j].y) + (v[q][j].z * v[q][j].z + v[q][j].w * v[q][j].w); } } }
#pragma unroll
        for (int q = 0; q < 2; ++q) { const int m = m0 + q * NGW; if (m < T) {
            const float rstd = 1.f / sqrtf(wave_sum(ssq[q]) * (1.f / D) + NORM_EPS);
            GAS f32x4* o = (GAS f32x4*)(F.out + (size_t)m * D) + lane;
#pragma unroll
            for (int j = 0; j < 4; ++j) o[64 * j] = v[q][j] * rstd * ((const f32x4*)F.in[31])[lane + 64 * j]; } }
    }
}

struct Args { const float* in[32]; float* out; unsigned char* ws; int ph_lo, ph_hi; };
__global__ void __launch_bounds__(NWAVES * 64, 2) fwd(Args args) {
    extern __shared__ __attribute__((aligned(16))) unsigned char lds[];
    Frame F;
    F.lds = (LAS unsigned char*)lds;
    F.MISC = (volatile LAS unsigned*)(F.lds + MISC_OFF);
    F.tid = threadIdx.x; F.lane = F.tid & 63; F.wave = __builtin_amdgcn_readfirstlane(F.tid >> 6);
    F.G = gridDim.x; { const int bx = blockIdx.x; F.vcu = (F.G % 8 == 0) ? (bx % 8) * (F.G / 8) + bx / 8 : bx; }
#pragma unroll
    for (int i = 0; i < 32; ++i) F.in[i] = args.in[i];
    F.out = args.out; F.ws = args.ws; F.ctl = (gu32*)(args.ws + WS_CTL);
    for (int u = F.tid; u < 128; u += NWAVES * 64) ((LAS unsigned*)(F.lds + LDSCTL_OFF))[u] = 0u;
    __syncthreads();
    XcdBarrier bar; bar.bar = (unsigned*)(F.ctl + CW_BAR); bar.x = 0; bar.st = nullptr;
#if !MK_PER_PHASE
    bar = xcd_barrier_post((unsigned*)(F.ctl + CW_BAR), F.MISC + 8);
#define GRID_BAR() xcd_barrier(bar)
#else
#define GRID_BAR() do { } while (0)
#endif
    const int lo = args.ph_lo, hi = args.ph_hi;
#ifndef PHMASK
#define PHMASK 0x7fff
#endif
#define IN(k) (((PHMASK >> (k)) & 1) && lo <= (k) && (k) < hi)
#define SEAM(k) do { if ((k) != 6 && IN(k) && IN((k) + 1)) GRID_BAR(); } while (0)
#ifndef PROBE_REPEAT
#define PROBE_REPEAT 0
#endif
#define PHASE(k, ...) do { if (IN(k)) { { __VA_ARGS__ } if ((PROBE_REPEAT >> (k)) & 1) { __VA_ARGS__ } } } while (0)
    using pg8::bf16_t;
    PHASE(0,  p0_prologue(F); ); SEAM(0);
    PHASE(1,  ln_phase<false>(F, F.in[0], F.in[4], 0, 1024, WSP(bf16, WS_H1)); ); SEAM(1);
    PHASE(2,  pg8::Gemm g{WSP(bf16_t, WS_H1), WSP(bf16_t, WS_WIN), 1024}; pg8::StaticOrder S; S.init(T, 4096, F.G, (int)blockIdx.x);
        pg8::EpiInProj E{WSP(bf16_t, WS_QKVU), WSP(bf16_t, WS_GATES), 0.125f * LOG2E};
        pg8::gemm_phase<pg8::EpiInProj, pg8::StaticOrder, true>(F.lds + RING_OFF, g, S, E); ); SEAM(2);
    PHASE(3,
        ssm_phase<1>(F);
        __syncthreads();
        { LAS float* tabs = (LAS float*)(F.lds + ATT_TAB_OFF); const float* tb = WSP(float, WS_TAB + TAB_BIAS); const float* b31g = WSP(float, WS_TAB + TAB_B31);
          for (int i = F.tid; i < 4 * attn_body::TABN; i += NWAVES * 64) tabs[i] = tb[i];
          if (F.tid < 4) tabs[4 * attn_body::TABN + F.tid] = b31g[F.tid]; }
        __syncthreads();
        const attn_body::AttnTensors AT{(const attn_body::bf16*)WSP(bf16, WS_QKVU), (attn_body::bf16*)WSP(bf16, WS_OV), (attn_body::lds_fptr)(F.lds + ATT_TAB_OFF), (attn_body::lds_fptr)(F.lds + ATT_TAB_OFF) + 4 * attn_body::TABN};
        const attn_body::StaticOrder S((int)F.G, F.vcu);
        attn_body::attn_phase<attn_body::StaticOrder>((char*)lds + RING_OFF, AT, S);
    ); SEAM(3);
    PHASE(4,  ssm_phase<2>(F); attn_combine_phase(F); ); SEAM(4);
    PHASE(5,  pg8::Gemm g{WSP(bf16_t, WS_YSSM), WSP(bf16_t, WS_WGLU), 512}; pg8::StaticOrder S; S.init(T, 1024, F.G, (int)blockIdx.x);
        pg8::EpiGate<0> E{WSP(bf16_t, WS_S), 512};
        pg8::gemm_phase<pg8::EpiGate<0>, pg8::StaticOrder, true>(F.lds + RING_OFF, g, S, E); ); SEAM(5);
    PHASE(6,  pg8::Gemm g{WSP(bf16_t, WS_YATTN), WSP(bf16_t, WS_WPA), 512}; pg8::ChainOrder S; S.so.init(T, 1024, F.G, (int)blockIdx.x);
        S.arow_off = (unsigned)((WS_S - WS_YATTN) / 1024); S.bt_off = (int)((WS_WPS - WS_WPA) / (256 * 512 * 2));
        pg8::EpiMerge E{WSP(bf16_t, WS_GATES), WSP(bf16_t, WS_MERGED)};
        pg8::gemm_phase<pg8::EpiMerge, pg8::ChainOrder, true>(F.lds + RING_OFF, g, S, E); ); SEAM(6);
    SEAM(7);
    PHASE(8,  pg8::Gemm g{WSP(bf16_t, WS_MERGED), WSP(bf16_t, WS_WOUT), 1024}; pg8::StaticOrder S; S.init(T, 1024, F.G, (int)blockIdx.x);
        pg8::EpiResid E{F.in[0], WSP(float, WS_MOD), WSP(bf16_t, WS_X1)};
        pg8::gemm_phase<pg8::EpiResid, pg8::StaticOrder, true>(F.lds + RING_OFF, g, S, E); ); SEAM(8);
    PHASE(9,  ln_phase<true>(F, WSP(bf16, WS_X1), F.in[24], 3072, 4096, WSP(bf16, WS_H2)); ); SEAM(9);
    PHASE(10,  pg8::Gemm g{WSP(bf16_t, WS_H2), WSP(bf16_t, WS_WR), 1024}; pg8::StaticOrder S; S.init(T, 256, F.G, (int)blockIdx.x);
        pg8::EpiRouter E{WSP(float, WS_LOGITS)};
        pg8::gemm_phase<pg8::EpiRouter, pg8::StaticOrder, true>(F.lds + RING_OFF, g, S, E); ); SEAM(10);
    PHASE(11,  routing_phase(F); ); SEAM(11);
    PHASE(12,  const int MT = expert_tables(F);
        LAS int* rowtab = (LAS int*)(F.lds + TBL_ROWTAB); const LAS int* tile_e = (const LAS int*)(F.lds + TBL_TILE_E); const LAS int* tstart = (const LAS int*)(F.lds + TBL_TSTART); const LAS int* cnt = (const LAS int*)(F.lds + TBL_CNT);
        const int* list = WSP(int, WS_LIST);
        for (int ui = 0; ui < ROWTAB_UNITS; ++ui) { const int L = ui * F.G + F.vcu; if (L >= MT * 4) break;
            if (F.tid < 256) { const int mt = L >> 2, e = tile_e[mt], rank = ((mt - tstart[e]) << 8) + F.tid; rowtab[ui * 256 + F.tid] = rank < cnt[e] ? list[(size_t)e * T + rank] : 0; } }
        __syncthreads();
        pg8::Gemm g{WSP(bf16_t, WS_H2), WSP(bf16_t, WS_WE1), 1024}; pg8::ExpertOrder S{tile_e, rowtab, MT, F.G, F.vcu, true};
        pg8::EpiGate<1> E{WSP(bf16_t, WS_ACT), 512};
        pg8::gemm_phase<pg8::EpiGate<1>, pg8::ExpertOrder, true>(F.lds + RING_OFF, g, S, E); ); SEAM(12);
    PHASE(13,  const int MT = expert_tables(F);
        const LAS int* tile_e = (const LAS int*)(F.lds + TBL_TILE_E);
        pg8::Gemm g{WSP(bf16_t, WS_ACT), WSP(bf16_t, WS_WE2), 512}; pg8::ExpertOrder S{tile_e, nullptr, MT, F.G, F.vcu, false};
        pg8::EpiPlain E{WSP(bf16_t, WS_YS), 1024};
        pg8::gemm_phase<pg8::EpiPlain, pg8::ExpertOrder, true>(F.lds + RING_OFF, g, S, E); ); SEAM(13);
    PHASE(14,  final_phase(F); );
#undef IN
#undef SEAM
#undef PHASE
}

extern "C" void kernel_launch(void* const* d_in, const int* in_sizes, int n_in, void* d_out, int out_size, void* d_ws, size_t ws_size, hipStream_t stream) {
    static int grid = 0;
    if (grid == 0) {
        if (n_in != 32 || out_size != T * D || ws_size < WS_END) { fprintf(stderr, "kernel_launch: unexpected shapes (n_in %d out %d ws %zu)\n", n_in, out_size, ws_size); grid = -1; return; }
        int dev = 0, cus = 0, per_cu = 0;
        if (hipGetDevice(&dev) != hipSuccess || hipDeviceGetAttribute(&cus, hipDeviceAttributeMultiprocessorCount, dev) != hipSuccess) { grid = -1; return; }
        if (hipFuncSetAttribute((const void*)fwd, hipFuncAttributeMaxDynamicSharedMemorySize, LDS_BYTES) != hipSuccess) { fprintf(stderr, "kernel_launch: hipFuncSetAttribute failed\n"); grid = -1; return; }
        if (hipOccupancyMaxActiveBlocksPerMultiprocessor(&per_cu, (const void*)fwd, NWAVES * 64, LDS_BYTES) != hipSuccess || per_cu < 1) fprintf(stderr, "kernel_launch: occupancy query reports %d\n", per_cu);
        (void)hipGetLastError();
        grid = cus;
    }
    if (grid < 0) return;
    if (hipMemsetAsync((char*)d_ws + WS_CTL, 0, CTL_ZERO_BYTES, stream) != hipSuccess) return;
    Args a{};
    for (int i = 0; i < 32; ++i) a.in[i] = (const float*)d_in[i];
    a.out = (float*)d_out; a.ws = (unsigned char*)d_ws;
#if MK_PER_PHASE
    for (int p = 0; p < NPH; ++p) { a.ph_lo = p; a.ph_hi = p + 1; hipLaunchKernelGGL(fwd, dim3(grid), dim3(NWAVES * 64), LDS_BYTES, stream, a); }
#else
    a.ph_lo = 0; a.ph_hi = NPH; hipLaunchKernelGGL(fwd, dim3(grid), dim3(NWAVES * 64), LDS_BYTES, stream, a);
#endif
}
```

```cpp
#include <hip/hip_runtime.h>
#include <hip/hip_bf16.h>
#include <cstdio>
#include <cstdint>
#include <cmath>

#ifndef MK_PER_PHASE
#define MK_PER_PHASE 0
#endif

namespace pg8 {
#define PG8_LAS __attribute__((address_space(3)))
typedef unsigned short bf16_t;
typedef short bf16x8 __attribute__((ext_vector_type(8)));
typedef float f32x4 __attribute__((ext_vector_type(4)));
typedef unsigned u32x4 __attribute__((ext_vector_type(4)));
constexpr int BM = 256, BK = 64, HALF = 128, HTB = HALF * BK * 2  , STAGE_BYTES = 8 * HTB, NXCD = 8, WGM = 8;

__host__ __device__ __forceinline__ int lds_byte(int r, int c) { const int st = (r >> 4) * 2 + (c >> 5), rr = r & 15, cc = c & 31, ob = rr * 64 + cc * 2; return st * 1024 + (ob ^ (((ob >> 9) & 1) << 5)); }
__host__ __device__ __forceinline__ void stage_rc(int b, int& R, int& C) { const int st = b / 1024, sb = b % 1024, swz = sb ^ (((sb >> 9) & 1) << 5); R = (st >> 1) * 16 + swz / 64; C = (st & 1) * 32 + (swz % 64) / 2; }
__host__ __device__ __forceinline__ int perm32(int rho) { const int n = rho >> 4, i = rho & 15; return 8 * (i >> 2) + 4 * n + (i & 3); }

struct Unit { int pm, pn, pc, seg; };
struct Gemm { const bf16_t* A; const bf16_t* Bt; int K; };

struct StaticOrder {
    int nM, nN, nwg, G, c;
    __host__ __device__ void init(int M, int N, int G_, int c_) { nM = M / BM; nN = N / BM; nwg = nM * nN; G = G_; c = c_; }
    __host__ __device__ bool next(int i, Unit& u) const {
        const long L = (long)i * G + c; if (L >= nwg) return false;
        int wgid = (int)L; { const int q = nwg / NXCD, r = nwg % NXCD, xcd = wgid % NXCD, off = wgid / NXCD; wgid = (xcd < r ? xcd * (q + 1) : r * (q + 1) + (xcd - r) * q) + off; }
        const int nig = WGM * nN, gid = wgid / nig, fm = gid * WGM, gsz = (nM - fm) < WGM ? (nM - fm) : WGM;
        u.pm = fm + ((wgid % nig) % gsz); u.pn = (wgid % nig) / gsz; u.pc = u.pn; u.seg = 0; return true;
    }
    __device__ __forceinline__ void arows(const Unit& u, int, int R0, int R1, unsigned (&r)[2][2]) const {
        r[0][0] = u.pm * BM + R0; r[0][1] = u.pm * BM + R1; r[1][0] = u.pm * BM + HALF + R0; r[1][1] = u.pm * BM + HALF + R1; }
};
struct ChainOrder {
    StaticOrder so; unsigned arow_off; int bt_off;
    __device__ __forceinline__ bool next(int i, Unit& u) const { if (!so.next(i >> 1, u)) return false; u.seg = i & 1; if (u.seg) u.pn += bt_off; return true; }
    __device__ __forceinline__ void arows(const Unit& u, int, int R0, int R1, unsigned (&r)[2][2]) const {
        const unsigned b = u.pm * BM + (u.seg ? arow_off : 0u); r[0][0] = b + R0; r[0][1] = b + R1; r[1][0] = b + HALF + R0; r[1][1] = b + HALF + R1; }
};
struct ExpertOrder {
    const PG8_LAS int* tile_e; const PG8_LAS int* rowtab; int MT, G, c; bool gather;
    __device__ __forceinline__ bool next(int i, Unit& u) const {
        const int L = i * G + c; if (L >= MT * 4) return false;
        const int mt = L >> 2, nt = L & 3; const int e = tile_e[mt]; u.pm = mt; u.pn = e * 4 + nt; u.pc = nt; u.seg = 0; return true; }
    __device__ __forceinline__ void arows(const Unit& u, int ui, int R0, int R1, unsigned (&r)[2][2]) const {
        if (gather) { const PG8_LAS int* t = rowtab + ui * BM; r[0][0] = (unsigned)t[R0]; r[0][1] = (unsigned)t[R1]; r[1][0] = (unsigned)t[HALF + R0]; r[1][1] = (unsigned)t[HALF + R1]; }
        else { r[0][0] = u.pm * BM + R0; r[0][1] = u.pm * BM + R1; r[1][0] = u.pm * BM + HALF + R0; r[1][1] = u.pm * BM + HALF + R1; } }
};

__device__ __forceinline__ unsigned cvt_pk_bf16(float lo, float hi) { unsigned r; asm volatile("v_cvt_pk_bf16_f32 %0, %1, %2" : "=v"(r) : "v"(lo), "v"(hi)); return r; }
__device__ __forceinline__ float bf_lo(unsigned w) { return __uint_as_float(w << 16); }
__device__ __forceinline__ float bf_hi(unsigned w) { return __uint_as_float(w & 0xffff0000u); }
__device__ __forceinline__ float sigm(float x) { return __builtin_amdgcn_rcpf(1.f + __builtin_amdgcn_exp2f(-1.4426950408889634f * x)); }
__device__ __forceinline__ u32x4 pack8(const f32x4& v0, const f32x4& v1) { u32x4 w; w.x = cvt_pk_bf16(v0[0], v0[1]); w.y = cvt_pk_bf16(v0[2], v0[3]); w.z = cvt_pk_bf16(v1[0], v1[1]); w.w = cvt_pk_bf16(v1[2], v1[3]); return w; }

struct EpiInProj { static constexpr bool PERM = true;
    bf16_t* qkvu; bf16_t* gates; float qscale;
    __device__ __forceinline__ bool operator()(f32x4 (&acc)[2][2][4][2], const Unit& u, int wr, int wc, int fr, int fq) const {
        const int row0 = u.pm * BM + wr * 64 + fr; const bool isg = u.pc >= 8;
        bf16_t* base = isg ? gates : qkvu; const int col0 = (u.pc & 7) * BM + wc * 32 + 8 * fq; const float sc = (u.pc < 2) ? qscale : 1.f;
#pragma unroll
        for (int ai = 0; ai < 2; ++ai)
#pragma unroll
            for (int m = 0; m < 4; ++m) { bf16_t* rowp = base + (size_t)(row0 + ai * HALF + m * 16) * 2048 + col0;
#pragma unroll
                for (int bj = 0; bj < 2; ++bj) { f32x4 v0 = acc[ai][bj][m][0], v1 = acc[ai][bj][m][1];
                    if (isg) {
#pragma unroll
                        for (int i = 0; i < 4; ++i) { v0[i] = sigm(v0[i]); v1[i] = sigm(v1[i]); } }
                    else { v0 = v0 * sc; v1 = v1 * sc; }
                    *(u32x4*)(rowp + bj * HALF) = pack8(v0, v1); } }
        return false;
    }
};
template <int MODE> struct EpiGate { static constexpr bool PERM = true;
    bf16_t* O; int ldc;
    __device__ __forceinline__ bool operator()(f32x4 (&acc)[2][2][4][2], const Unit& u, int wr, int wc, int fr, int fq) const {
        const int row0 = u.pm * BM + wr * 64 + fr; const int col0 = u.pc * HALF + wc * 32 + 8 * fq;
#pragma unroll
        for (int ai = 0; ai < 2; ++ai)
#pragma unroll
            for (int m = 0; m < 4; ++m) { f32x4 r0, r1;
#pragma unroll
                for (int i = 0; i < 4; ++i) { const float a0 = acc[ai][0][m][0][i], a1 = acc[ai][0][m][1][i], g0 = acc[ai][1][m][0][i], g1 = acc[ai][1][m][1][i];
                    if (MODE == 0) { r0[i] = a0 * sigm(g0); r1[i] = a1 * sigm(g1); } else { r0[i] = a0 * sigm(a0) * g0; r1[i] = a1 * sigm(a1) * g1; } }
                *(u32x4*)(O + (size_t)(row0 + ai * HALF + m * 16) * ldc + col0) = pack8(r0, r1); }
        return false;
    }
};
struct EpiMerge { static constexpr bool PERM = true;
    const bf16_t* gates; bf16_t* out;
    __device__ __forceinline__ bool operator()(f32x4 (&acc)[2][2][4][2], const Unit& u, int wr, int wc, int fr, int fq) const {
        const int row0 = u.pm * BM + wr * 64 + fr; const int col0 = u.pc * BM + wc * 32 + 8 * fq;
#pragma unroll
        for (int ai = 0; ai < 2; ++ai)
#pragma unroll
            for (int m = 0; m < 4; ++m) { const size_t r = (size_t)(row0 + ai * HALF + m * 16);
#pragma unroll
                for (int bj = 0; bj < 2; ++bj) { const int c = col0 + bj * HALF;
                    const u32x4 gs = *(const u32x4*)(gates + r * 2048 + 1024 + c);
                    f32x4 s0, s1; s0[0] = bf_lo(gs.x); s0[1] = bf_hi(gs.x); s0[2] = bf_lo(gs.y); s0[3] = bf_hi(gs.y); s1[0] = bf_lo(gs.z); s1[1] = bf_hi(gs.z); s1[2] = bf_lo(gs.w); s1[3] = bf_hi(gs.w);
                    if (u.seg == 0) { const u32x4 ga = *(const u32x4*)(gates + r * 2048 + c);
                        f32x4 a0, a1; a0[0] = bf_lo(ga.x); a0[1] = bf_hi(ga.x); a0[2] = bf_lo(ga.y); a0[3] = bf_hi(ga.y); a1[0] = bf_lo(ga.z); a1[1] = bf_hi(ga.z); a1[2] = bf_lo(ga.w); a1[3] = bf_hi(ga.w);
#pragma unroll
                        for (int i = 0; i < 4; ++i) { acc[ai][bj][m][0][i] *= a0[i] / s0[i]; acc[ai][bj][m][1][i] *= a1[i] / s1[i]; } }
                    else { *(u32x4*)(out + r * 1024 + c) = pack8(acc[ai][bj][m][0] * s0, acc[ai][bj][m][1] * s1); } } }
        return u.seg == 0;
    }
};
struct EpiResid { static constexpr bool PERM = true;
    const float* x; const float* mod; bf16_t* x1;
    __device__ __forceinline__ bool operator()(f32x4 (&acc)[2][2][4][2], const Unit& u, int wr, int wc, int fr, int fq) const {
        const int row0 = u.pm * BM + wr * 64 + fr; const int col0 = u.pc * BM + wc * 32 + 8 * fq; const float* gp = mod + (size_t)(u.pm >> 4) * 6144 + 2048;
        f32x4 gv[2][2];
#pragma unroll
        for (int bj = 0; bj < 2; ++bj) { gv[bj][0] = *(const f32x4*)(gp + col0 + bj * HALF); gv[bj][1] = *(const f32x4*)(gp + col0 + bj * HALF + 4); }
#pragma unroll
        for (int ai = 0; ai < 2; ++ai)
#pragma unroll
            for (int m = 0; m < 4; ++m) { const size_t off = (size_t)(row0 + ai * HALF + m * 16) * 1024 + col0;
#pragma unroll
                for (int bj = 0; bj < 2; ++bj) { const f32x4 x0 = *(const f32x4*)(x + off + bj * HALF), x1v = *(const f32x4*)(x + off + bj * HALF + 4);
                    *(u32x4*)(x1 + off + bj * HALF) = pack8(x0 + gv[bj][0] * acc[ai][bj][m][0], x1v + gv[bj][1] * acc[ai][bj][m][1]); } }
        return false;
    }
};
struct EpiRouter { static constexpr bool PERM = true;
    float* logits;
    __device__ __forceinline__ bool operator()(f32x4 (&acc)[2][2][4][2], const Unit& u, int wr, int wc, int fr, int fq) const {
        if (wc >= 2) return false;
        const int row0 = u.pm * BM + wr * 64 + fr; const int col0 = wc * 32 + 8 * fq;
#pragma unroll
        for (int ai = 0; ai < 2; ++ai)
#pragma unroll
            for (int m = 0; m < 4; ++m) { float* p = logits + (size_t)(row0 + ai * HALF + m * 16) * 64 + col0; *(f32x4*)p = acc[ai][0][m][0]; *(f32x4*)(p + 4) = acc[ai][0][m][1]; }
        return false;
    }
};
struct EpiPlain { static constexpr bool PERM = true;
    bf16_t* O; int ldc;
    __device__ __forceinline__ bool operator()(f32x4 (&acc)[2][2][4][2], const Unit& u, int wr, int wc, int fr, int fq) const {
        const int row0 = u.pm * BM + wr * 64 + fr; const int col0 = u.pc * BM + wc * 32 + 8 * fq;
#pragma unroll
        for (int ai = 0; ai < 2; ++ai)
#pragma unroll
            for (int m = 0; m < 4; ++m) { bf16_t* rowp = O + (size_t)(row0 + ai * HALF + m * 16) * ldc + col0;
#pragma unroll
                for (int bj = 0; bj < 2; ++bj) *(u32x4*)(rowp + bj * HALF) = pack8(acc[ai][bj][m][0], acc[ai][bj][m][1]); }
        return false;
    }
};

template <class Epi, class Sched, bool ALIGN_EPI>
__device__ __forceinline__ void gemm_phase(PG8_LAS unsigned char* lds, const Gemm g, const Sched& S, const Epi& E) {
    const int tid = threadIdx.x, wid = __builtin_amdgcn_readfirstlane(tid >> 6), lane = tid & 63, wr = wid >> 2, wc = wid & 3, fr = lane & 15, fq = lane >> 4;
    const int K = g.K, nt = K / BK;
    int Rr[2], Cc[2]; unsigned voffB[2];
#pragma unroll
    for (int i = 0; i < 2; ++i) { int R, C; stage_rc(tid * 16 + i * 8192, R, C); const int Rb = Epi::PERM ? ((R & ~31) + perm32(R & 31)) : R;
        Rr[i] = R; Cc[i] = C; voffB[i] = (unsigned)(Rb * K + C) * 2u; }
    const size_t kstep = (size_t)(BK * 2);
    const size_t hstep = (size_t)HALF * K * 2;
    const size_t tstep = 2 * hstep;
    const unsigned ldsw = (unsigned)wid * 1024u;
    const int aoff = lds_byte(wr * 64 + fr, fq * 8), boff = lds_byte(wc * 32 + fr, fq * 8);
#define PG8_SA(b, h) (((b) * 2 + (h)) * HTB)
#define PG8_SB(b, h) ((4 + (b) * 2 + (h)) * HTB)
#define PG8_STAGE(bufoff, gbase, voff) do { _Pragma("unroll") for (int _i = 0; _i < 2; ++_i) \
        __builtin_amdgcn_global_load_lds((const unsigned*)((const char*)(gbase) + (voff)[_i]), (PG8_LAS unsigned*)(lds + (bufoff) + ldsw + _i * 8192), 16, 0, 0); } while (0)
#define PG8_LDA(dst, b, h) do { _Pragma("unroll") for (int m = 0; m < 4; ++m) _Pragma("unroll") for (int k = 0; k < 2; ++k) dst[m][k] = *(const PG8_LAS bf16x8*)(lds + PG8_SA(b, h) + aoff + m * 2048 + k * 1024); } while (0)
#define PG8_LDB(dst, b, h) do { _Pragma("unroll") for (int n = 0; n < 2; ++n) _Pragma("unroll") for (int k = 0; k < 2; ++k) dst[n][k] = *(const PG8_LAS bf16x8*)(lds + PG8_SB(b, h) + boff + n * 2048 + k * 1024); } while (0)
#define PG8_MMA(ai, bj, At, Bt) do { __builtin_amdgcn_s_setprio(1); _Pragma("unroll") for (int m = 0; m < 4; ++m) _Pragma("unroll") for (int n = 0; n < 2; ++n) _Pragma("unroll") for (int k = 0; k < 2; ++k) \
        acc[ai][bj][m][n] = __builtin_amdgcn_mfma_f32_16x16x32_bf16(Bt[n][k], At[m][k], acc[ai][bj][m][n], 0, 0, 0); __builtin_amdgcn_s_setprio(0); } while (0)
#define PG8_WAIT_V(n) asm volatile("s_waitcnt vmcnt(" #n ")" ::: "memory")
#define PG8_WAIT_L(n) asm volatile("s_waitcnt lgkmcnt(" #n ")" ::: "memory")
#define PG8_BAR __builtin_amdgcn_s_barrier()
#define PG8_SCHED __builtin_amdgcn_sched_barrier(0)
#define PG8_MKOFF(u_, ui_, v_) do { unsigned r_[2][2]; S.arows(u_, ui_, Rr[0], Rr[1], r_); _Pragma("unroll") for (int h_ = 0; h_ < 2; ++h_) _Pragma("unroll") for (int i_ = 0; i_ < 2; ++i_) \
        v_[h_][i_] = (r_[h_][i_] * (unsigned)K + (unsigned)Cc[i_]) * 2u; } while (0)
    Unit cur, nxt; int ui = 0;
    if (!S.next(0, cur)) return;
    unsigned vc[2][2], vn[2][2];
    PG8_MKOFF(cur, 0, vc);
    f32x4 acc[2][2][4][2];
#pragma unroll
    for (int a = 0; a < 2; ++a)
#pragma unroll
        for (int b = 0; b < 2; ++b)
#pragma unroll
            for (int m = 0; m < 4; ++m)
#pragma unroll
                for (int n = 0; n < 2; ++n) acc[a][b][m][n] = (f32x4){0.f, 0.f, 0.f, 0.f};
    bf16x8 At[4][2], B0[2][2], B1[2][2];
    const char* Ab = (const char*)g.A; const char* cB = (const char*)g.Bt + (size_t)cur.pn * tstep;
    PG8_STAGE(PG8_SB(0, 0), cB, voffB); PG8_STAGE(PG8_SB(0, 1), cB + hstep, voffB); PG8_STAGE(PG8_SA(0, 0), Ab, vc[0]); PG8_STAGE(PG8_SA(0, 1), Ab, vc[1]);
    if (wr == 1) PG8_BAR;
    PG8_WAIT_V(2); PG8_BAR;
    PG8_STAGE(PG8_SB(1, 0), cB + kstep, voffB); PG8_STAGE(PG8_SA(1, 0), Ab + kstep, vc[0]); PG8_STAGE(PG8_SB(1, 1), cB + hstep + kstep, voffB);
    PG8_WAIT_V(6); PG8_BAR;
    for (;;) {
        const bool has_next = S.next(ui + 1, nxt);
        if (has_next) { PG8_MKOFF(nxt, ui + 1, vn); } else { vn[0][0] = vc[0][0]; vn[0][1] = vc[0][1]; vn[1][0] = vc[1][0]; vn[1][1] = vc[1][1]; }
        const char* nB = has_next ? (const char*)g.Bt + (size_t)nxt.pn * tstep : cB;
        for (int t = 0; t < nt; t += 2) {
            const bool last = (t == nt - 2);
            const char* a1 = Ab + (size_t)(t + 1) * kstep;
            const char* a2 = last ? Ab : Ab + (size_t)(t + 2) * kstep; const char* b2 = last ? nB : cB + (size_t)(t + 2) * kstep;
            const char* a3 = a2 + kstep; const char* b3 = b2 + kstep;
            unsigned vs[2][2];
#pragma unroll
            for (int h = 0; h < 2; ++h)
#pragma unroll
                for (int i = 0; i < 2; ++i) vs[h][i] = last ? vn[h][i] : vc[h][i];
            PG8_LDB(B0, 0, 0); PG8_LDB(B1, 0, 1); PG8_SCHED; PG8_LDA(At, 0, 0); PG8_STAGE(PG8_SA(1, 1), a1, vc[1]);
            PG8_WAIT_V(8); PG8_WAIT_L(0); PG8_BAR; PG8_MMA(0, 0, At, B0); PG8_MMA(0, 1, At, B1); PG8_BAR; PG8_SCHED;
            PG8_LDA(At, 0, 1); PG8_STAGE(PG8_SB(0, 0), b2, voffB); PG8_STAGE(PG8_SB(0, 1), b2 + hstep, voffB); PG8_STAGE(PG8_SA(0, 0), a2, vs[0]);
            PG8_WAIT_V(8); PG8_WAIT_L(0); PG8_BAR; PG8_MMA(1, 0, At, B0); PG8_MMA(1, 1, At, B1); PG8_BAR; PG8_SCHED;
            PG8_LDB(B0, 1, 0); PG8_LDB(B1, 1, 1); PG8_SCHED; PG8_LDA(At, 1, 0); PG8_STAGE(PG8_SA(0, 1), a2, vs[1]);
            PG8_WAIT_V(8); PG8_WAIT_L(0); PG8_BAR; PG8_MMA(0, 0, At, B0); PG8_MMA(0, 1, At, B1); PG8_BAR; PG8_SCHED;
            PG8_LDA(At, 1, 1); PG8_STAGE(PG8_SB(1, 0), b3, voffB); PG8_STAGE(PG8_SB(1, 1), b3 + hstep, voffB); PG8_STAGE(PG8_SA(1, 0), a3, vs[0]);
            PG8_WAIT_V(8); PG8_WAIT_L(0); PG8_BAR; PG8_MMA(1, 0, At, B0); PG8_MMA(1, 1, At, B1); PG8_BAR; PG8_SCHED;
        }
        if constexpr (ALIGN_EPI) { if (wr == 0) PG8_BAR; }
        const bool keep = E(acc, cur, wr, wc, fr, fq);
        if (!has_next) break;
        if (!keep) {
#pragma unroll
        for (int a = 0; a < 2; ++a)
#pragma unroll
            for (int b = 0; b < 2; ++b)
#pragma unroll
                for (int m = 0; m < 4; ++m)
#pragma unroll
                    for (int n = 0; n < 2; ++n) acc[a][b][m][n] = (f32x4){0.f, 0.f, 0.f, 0.f};
        }
        cur = nxt; cB = nB; ++ui;
        vc[0][0] = vn[0][0]; vc[0][1] = vn[0][1]; vc[1][0] = vn[1][0]; vc[1][1] = vn[1][1];
        if constexpr (ALIGN_EPI) { if (wr == 1) PG8_BAR; }
    }
    PG8_WAIT_V(0);
    if constexpr (!ALIGN_EPI) { if (wr == 0) PG8_BAR; }
    PG8_BAR;
#undef PG8_SA
#undef PG8_SB
#undef PG8_STAGE
#undef PG8_LDA
#undef PG8_LDB
#undef PG8_MMA
#undef PG8_WAIT_V
#undef PG8_WAIT_L
#undef PG8_BAR
#undef PG8_SCHED
#undef PG8_MKOFF
}
}

namespace attn_body {
using bf16=__hip_bfloat16;
using bf16x8=__attribute__((ext_vector_type(8)))short;
using s16x4=__attribute__((ext_vector_type(4)))short;
using f32x16=__attribute__((ext_vector_type(16)))float;
using u32x4=__attribute__((ext_vector_type(4)))unsigned;
constexpr int BATCH=16,NHM=8,SEQ=4096,D=64,DM=1024;
constexpr int PQ=2048;
constexpr int TABN=640;
constexpr int QB=256,KVBLK=64,NQB=SEQ/QB;
__device__ __forceinline__ int crow(int r,int hi){return (r&3)+8*(r>>2)+4*hi;}
#define SBAR() __builtin_amdgcn_sched_barrier(0)
typedef __attribute__((address_space(3))) const float* lds_fptr;
typedef __attribute__((address_space(3))) float* lds_fwptr;
typedef __attribute__((address_space(3))) const char* lds_cptr;
typedef __attribute__((address_space(3))) u32x4* lds_u4p;
typedef short v4i16_t __attribute__((ext_vector_type(4)));
__device__ __forceinline__ void cmask(f32x16&p0,f32x16&p1,int dt,int qrel,int hi,lds_fptr tab){
  lds_fptr t=tab+(64*dt+qrel-4*hi+255-59);
  #pragma unroll
  for(int r=0;r<16;++r){p0[r]+=t[59-((r&3)+8*(r>>2))]; p1[r]+=t[27-((r&3)+8*(r>>2))]; if((r&3)==3)SBAR();}
}
constexpr int NKS=3,KSLOT=8192,NVS=3,VSLOT=16384;
constexpr int LDS_K=0,LDS_V=NKS*KSLOT,LDS_WS=LDS_V+NVS*VSLOT,LDS_BYTES=LDS_WS+8*256,LDS_OST=0;
__device__ __forceinline__ void glds16(const void*gsrc,unsigned lds_dst){unsigned keep;
  asm volatile("s_mov_b32 %0, m0\n\ts_mov_b32 m0, %2\n\ts_nop 0\n\tglobal_load_lds_dwordx4 %1, off\n\ts_mov_b32 m0, %0":"=&s"(keep):"v"(gsrc),"s"(lds_dst):"memory");}
__device__ __forceinline__ float max3f(float a,float b,float c){float r;asm("v_max3_f32 %0, %1, %2, %3":"=v"(r):"v"(a),"v"(b),"v"(c));return r;}
__device__ __forceinline__ float max2f(float a,float b){float r;asm("v_max_f32_e32 %0, %1, %2":"=v"(r):"v"(a),"v"(b));return r;}
typedef float f32x2_t __attribute__((ext_vector_type(2))); typedef __bf16 bf16x2_t __attribute__((ext_vector_type(2)));
__device__ __forceinline__ unsigned cvtpk_s(float lo,float hi){f32x2_t v={lo,hi};bf16x2_t b=__builtin_convertvector(v,bf16x2_t);return __builtin_bit_cast(unsigned,b);}
#define WAIT_BAR(N) asm volatile("s_waitcnt vmcnt(" #N ") lgkmcnt(0)\n\ts_barrier":::"memory")
__device__ __forceinline__ void kload8(bf16x8*kf,lds_cptr kp){
  kf[0]=*(const __attribute__((address_space(3))) bf16x8*)(kp);      kf[1]=*(const __attribute__((address_space(3))) bf16x8*)(kp+512);
  kf[2]=*(const __attribute__((address_space(3))) bf16x8*)(kp+2048); kf[3]=*(const __attribute__((address_space(3))) bf16x8*)(kp+2560);
  kf[4]=*(const __attribute__((address_space(3))) bf16x8*)(kp+4096); kf[5]=*(const __attribute__((address_space(3))) bf16x8*)(kp+4608);
  kf[6]=*(const __attribute__((address_space(3))) bf16x8*)(kp+6144); kf[7]=*(const __attribute__((address_space(3))) bf16x8*)(kp+6656);
}
__device__ __forceinline__ s16x4 vtr(lds_cptr p){ return __builtin_bit_cast(s16x4,__builtin_amdgcn_ds_read_tr16_b64_v4i16((__attribute__((address_space(3))) v4i16_t*)p)); }
__device__ __forceinline__ float rowmax(const f32x16&p0,const f32x16&p1){
  float a=max3f(p0[0],p0[1],p1[0]),b=max3f(p0[2],p0[3],p1[1]);a=max3f(a,p1[2],p1[3]);
  #pragma unroll
  for(int r=4;r<16;r+=4){a=max3f(a,p0[r],p0[r+1]);b=max3f(b,p0[r+2],p0[r+3]);a=max3f(a,p1[r],p1[r+1]);b=max3f(b,p1[r+2],p1[r+3]);}
  const float m=max2f(a,b);
  auto rr=__builtin_amdgcn_permlane32_swap(__float_as_uint(m),__float_as_uint(m),false,false);
  return max2f(__uint_as_float(rr[0]),__uint_as_float(rr[1]));
}
#ifndef ATTN_STORE16
#define ATTN_STORE16(p,v) (*(u32x4*)(p)=(v))
#endif
template<int THRL> __device__ __forceinline__ void attn_unit(int b,int hm,int qb,const bf16*__restrict__ QKV,bf16*O,char*shm,lds_fptr tab,float b31){
  const int tid=threadIdx.x,lane=tid&63,r32=lane&31,hi=lane>>5; const int wid=__builtin_amdgcn_readfirstlane(tid>>6);
  const int hh=hm>>1,mm=hm&1;
  const long rowbase=(long)b*SEQ; const int q0=qb*QB;
  const bf16*Kh=QKV+rowbase*PQ+512+hh*128+mm*64,*Vh=QKV+rowbase*PQ+1024+hh*128;
  const unsigned lds0=(unsigned)(uintptr_t)shm;
  const lds_cptr shm3=(lds_cptr)shm;
  const lds_fwptr wsf=(lds_fwptr)(shm3+LDS_WS)+wid*64;
  const bf16*ksrc=Kh+(long)lane*PQ+wid*8;
  const bf16*vsrc=Vh+(long)(16*(wid&3)+(lane>>2))*PQ+(wid>>2)*32+(lane&3)*8;
  const unsigned kdst=lds0+LDS_K+wid*1024, vdst=lds0+LDS_V+wid*1024;
  #define DMA_K(t,slot) glds16(ksrc+(long)(t)*KVBLK*PQ,(unsigned)__builtin_amdgcn_readfirstlane(kdst+(slot)))
  #define DMA_V(t,slot) do{ glds16(vsrc+(long)(t)*KVBLK*PQ,(unsigned)__builtin_amdgcn_readfirstlane(vdst+(slot))); glds16(vsrc+64+(long)(t)*KVBLK*PQ,(unsigned)__builtin_amdgcn_readfirstlane(vdst+(slot)+8192)); }while(0)
  const lds_cptr kp0=shm3+LDS_K+hi*1024+r32*16; const lds_cptr vp0=shm3+LDS_V+((lane>>4)&1)*32+(lane&3)*8+(4*hi+((lane&15)>>2))*64;
  const int NT=(q0+QB)/KVBLK;
  int sl_cur=0,sl_next=KSLOT;
  int vs_cur=0,vs_next=VSLOT,vs_nn=2*VSLOT;
  #define ROT() do{sl_cur=sl_next;sl_next=(sl_next==(NKS-1)*KSLOT)?0:sl_next+KSLOT; vs_cur=vs_next;vs_next=vs_nn;vs_nn=(vs_nn==(NVS-1)*VSLOT)?0:vs_nn+VSLOT;}while(0)
  DMA_K(0,0);DMA_V(0,0);DMA_K(1,KSLOT);
  const bf16*Qw=QKV+(rowbase+q0+wid*32)*PQ+hh*128+mm*64;
  bf16x8 qx[4];
  #pragma unroll
  for(int d0=0;d0<4;++d0)qx[d0]=*reinterpret_cast<const bf16x8*>(&Qw[(long)r32*PQ+d0*16+hi*8]);
  float mh=0.f,lacc=0.f; f32x16 ng;
  #pragma unroll
  for(int r=0;r<16;++r)ng[r]=b31;
  f32x16 o[4];o[0]=f32x16{};o[1]=f32x16{};o[2]=f32x16{};o[3]=f32x16{};
  const int qrel=wid*32+r32;
  bf16x8 kf[8];
  DMA_K(2,2*KSLOT);DMA_V(1,VSLOT);
  WAIT_BAR(6);
  kload8(kf,kp0);
  WAIT_BAR(3);
  for(int t=0;t<NT;++t){
    const bool gk=(t+3<NT),gv2=(t+2<NT),gv=(t+1<NT);
    if(gk){DMA_K(t+3,sl_cur);} if(gv2){DMA_V(t+2,vs_nn);}
    f32x16 c0,c1;
    c0=__builtin_amdgcn_mfma_f32_32x32x16_bf16(kf[0],qx[0],ng,0,0,0); c1=__builtin_amdgcn_mfma_f32_32x32x16_bf16(kf[1],qx[0],ng,0,0,0);
    #pragma unroll
    for(int j=1;j<4;++j){ c0=__builtin_amdgcn_mfma_f32_32x32x16_bf16(kf[2*j],qx[j],c0,0,0,0); c1=__builtin_amdgcn_mfma_f32_32x32x16_bf16(kf[2*j+1],qx[j],c1,0,0,0); }
    SBAR();
    { const int dt=(NT-4)-t; if(dt<=2)cmask(c0,c1,dt,qrel,hi,tab); }
    SBAR();
    const float rm=rowmax(c0,c1); bool resc=false;
    if(t==0){ mh=rm;
      #pragma unroll
      for(int r=0;r<16;++r){c0[r]-=rm;c1[r]-=rm;}
      #pragma unroll
      for(int r=0;r<16;++r)ng[r]=b31-mh;
    } else if(__builtin_expect(__any(rm>(float)THRL),0)){ const float dl=__builtin_fmaxf(rm,0.f); mh+=dl;
      #pragma unroll
      for(int r=0;r<16;++r){c0[r]-=dl;c1[r]-=dl;}
      #pragma unroll
      for(int r=0;r<16;++r)ng[r]=b31-mh;
      const float f=__builtin_amdgcn_exp2f(-dl); lacc*=f; if(hi==0)wsf[r32]=f; resc=true; }
    if(gv) kload8(kf,kp0+sl_next);
    #pragma unroll
    for(int r=0;r<16;++r){c0[r]=__builtin_amdgcn_exp2f(c0[r]);c1[r]=__builtin_amdgcn_exp2f(c1[r]);}
    { float s0=(c0[0]+c0[1])+(c0[2]+c0[3]),s1=(c1[0]+c1[1])+(c1[2]+c1[3]);
      #pragma unroll
      for(int r=4;r<16;r+=4){s0+=(c0[r]+c0[r+1])+(c0[r+2]+c0[r+3]);s1+=(c1[r]+c1[r+1])+(c1[r+2]+c1[r+3]);}
      lacc+=s0+s1; }
    u32x4 w0,w1,w2,w3;
    w0=(u32x4){cvtpk_s(c0[0],c0[1]),cvtpk_s(c0[2],c0[3]),cvtpk_s(c0[4],c0[5]),cvtpk_s(c0[6],c0[7])};   w1=(u32x4){cvtpk_s(c0[8],c0[9]),cvtpk_s(c0[10],c0[11]),cvtpk_s(c0[12],c0[13]),cvtpk_s(c0[14],c0[15])};
    w2=(u32x4){cvtpk_s(c1[0],c1[1]),cvtpk_s(c1[2],c1[3]),cvtpk_s(c1[4],c1[5]),cvtpk_s(c1[6],c1[7])};   w3=(u32x4){cvtpk_s(c1[8],c1[9]),cvtpk_s(c1[10],c1[11]),cvtpk_s(c1[12],c1[13]),cvtpk_s(c1[14],c1[15])};
    bf16x8 pa[4]; pa[0]=__builtin_bit_cast(bf16x8,w0);pa[1]=__builtin_bit_cast(bf16x8,w1);pa[2]=__builtin_bit_cast(bf16x8,w2);pa[3]=__builtin_bit_cast(bf16x8,w3);
    if(resc){ asm volatile("s_waitcnt lgkmcnt(0)":::"memory");
      #pragma unroll
      for(int d_=0;d_<4;++d_)
        #pragma unroll
        for(int r=0;r<16;++r)o[d_][r]*=wsf[crow(r,hi)]; }
    SBAR();
    const lds_cptr vp=vp0+vs_cur;
    s16x4 alo[4],ahi[4],blo[4],bhi[4];
    #define VREAD(LO,HI,db) do{ _Pragma("unroll") for(int i_=0;i_<4;++i_){ const int off_=((db)>>1)*8192+((db)&1)*4096+i_*1024; LO[i_]=vtr(vp+off_); HI[i_]=vtr(vp+off_+512); } }while(0)
    #define VMMA(LO,HI,db) do{ _Pragma("unroll") for(int ks_=0;ks_<4;++ks_){ const bf16x8 vf_=(bf16x8){LO[ks_][0],LO[ks_][1],LO[ks_][2],LO[ks_][3],HI[ks_][0],HI[ks_][1],HI[ks_][2],HI[ks_][3]}; \
        o[db]=__builtin_amdgcn_mfma_f32_32x32x16_bf16(pa[ks_],vf_,o[db],0,0,0); } }while(0)
    VREAD(alo,ahi,0); SBAR(); VREAD(blo,bhi,1); SBAR();
    asm volatile("s_waitcnt lgkmcnt(8)":::"memory"); SBAR(); VMMA(alo,ahi,0); SBAR();
    VREAD(alo,ahi,2); SBAR();
    asm volatile("s_waitcnt lgkmcnt(8)":::"memory"); SBAR(); VMMA(blo,bhi,1); SBAR();
    VREAD(blo,bhi,3); SBAR();
    asm volatile("s_waitcnt lgkmcnt(8)":::"memory"); SBAR(); VMMA(alo,ahi,2); SBAR();
    asm volatile("s_waitcnt lgkmcnt(0)":::"memory"); SBAR(); VMMA(blo,bhi,3); SBAR();
    #undef VREAD
    #undef VMMA
    if(gk){WAIT_BAR(3);} else if(gv2){WAIT_BAR(2);} else {WAIT_BAR(0);}
    ROT();
  }
  {auto rr=__builtin_amdgcn_permlane32_swap(__float_as_uint(lacc),__float_as_uint(lacc),false,false);lacc=__uint_as_float(rr[0])+__uint_as_float(rr[1]);}
  if(hi==0)wsf[32+r32]=lacc;
  asm volatile("s_waitcnt vmcnt(0) lgkmcnt(0)":::"memory");
  bf16*Ow=O+(rowbase+q0+wid*32)*DM+(hm*2)*D;
  { bf16*stg=(bf16*)(shm+LDS_OST)+wid*4096;
    #pragma unroll
    for(int r=0;r<16;++r){const int orow=crow(r,hi); const float rl=__builtin_amdgcn_rcpf(wsf[32+orow]);
      #pragma unroll
      for(int d0=0;d0<4;++d0)stg[orow*128+d0*32+r32]=__float2bfloat16(o[d0][r]*rl);}
    asm volatile("s_waitcnt lgkmcnt(0)":::"memory");
    const bf16*sp=stg+(lane>>4)*128+(lane&15)*8; bf16*gp=Ow+(long)(lane>>4)*DM+(lane&15)*8;
    #pragma unroll 1
    for(int i=0;i<8;++i){ const u32x4 v=*(const u32x4*)sp; ATTN_STORE16(gp,v); sp+=4*128; gp+=4*DM; } }
  asm volatile("s_waitcnt lgkmcnt(0)\n\ts_barrier":::"memory");
  #undef DMA_K
  #undef DMA_V
  #undef ROT
}
constexpr int ATTN_LDS_BYTES=LDS_BYTES;
struct AttnTensors { const bf16* QKV; bf16* O; lds_fptr tabs; lds_fptr b31; };
struct AttnUnit { int bhm; int qb; };
struct StaticOrder {
  int vcu,G;
  __device__ __forceinline__ StaticOrder(int grid,int v):vcu(v),G(grid){}
  __device__ __forceinline__ bool next(int i,AttnUnit&u)const{
    if(G==256){ if(i>=8)return false; const int x=vcu>>5,c=vcu&31,half=c>>4,s=c&15; u.bhm=x*16+2*i+half; u.qb=(i&1)?(NQB-1-s):s; return true; }
    const int L=i*G+vcu; if(L>=BATCH*NHM*NQB)return false; u.bhm=L/NQB; u.qb=L%NQB; return true; }
};
template<class Sched,int THRL=8> __device__ __forceinline__ void attn_phase(char*lds,const AttnTensors&T,const Sched&S){
  AttnUnit u;
  for(int i=0;S.next(i,u);++i){ const int hm=u.bhm%NHM; attn_unit<THRL>(u.bhm/NHM,hm,u.qb,T.QKV,T.O,lds,T.tabs+(hm>>1)*TABN,T.b31[hm>>1]); }
}
#undef SBAR
#undef WAIT_BAR
}


constexpr int NWAVES = 8;
constexpr int BATCH = 16, SEQ = 4096, D = 1024, T = BATCH * SEQ;
constexpr int NPH = 15;
constexpr float NORM_EPS = 1e-6f, SUBLN_EPS = 1e-5f, LAMBDA_INIT = 0.2f, LOG2E = 1.4426950408889634f;

constexpr size_t MiB = 1u << 20;
constexpr size_t WS_CTL = 0, CTL_ZERO_BYTES = 2 * MiB;
constexpr size_t WS_MOD = 1 * MiB;
constexpr size_t WS_TAB = 2 * MiB;
constexpr size_t TAB_BBT = 0, TAB_CCT = 128 * 1024, TAB_A = 256 * 1024, TAB_AL = 272 * 1024, TAB_BIAS = 288 * 1024, TAB_B31 = 300 * 1024, TAB_LAM = 300 * 1024 + 64;
constexpr size_t WS_WIN = 4 * MiB, WS_WGLU = 12 * MiB, WS_WPA = 13 * MiB, WS_WPS = 14 * MiB, WS_WOUT = 15 * MiB, WS_WR = 17 * MiB, WS_WE1 = 18 * MiB, WS_WE2 = 82 * MiB;
constexpr size_t WS_QKVU = 128 * MiB, WS_GATES = 384 * MiB, WS_H1 = 640 * MiB, WS_OV = 640 * MiB, WS_TMP = 640 * MiB, WS_YATTN = 768 * MiB, WS_YSSM = 832 * MiB, WS_S = 896 * MiB,
                 WS_SSMEND = 960 * MiB, WS_MERGED = 128 * MiB, WS_X1 = 384 * MiB, WS_H2 = 896 * MiB, WS_LOGITS = 264 * MiB, WS_LIST = 280 * MiB, WS_TOK = 288 * MiB, WS_ACT = 128 * MiB, WS_YS = 640 * MiB,
                 WS_END = 1024 * MiB;
constexpr int CW_TMO = 0, CW_CODE = 1, CW_BAR = 4096, CW_CNT = 8192;

constexpr int RING_OFF = 0, RING_BYTES = 143360;
constexpr int LDSCTL_OFF = RING_BYTES, MISC_OFF = LDSCTL_OFF + 320;
constexpr int TBL_OFF = LDSCTL_OFF + 512;
constexpr int TBL_TILE_E = TBL_OFF, TBL_TSTART = TBL_OFF + 2304, TBL_CNT = TBL_TSTART + 256, TBL_ROWTAB = TBL_CNT + 128, ROWTAB_UNITS = 10;
constexpr int LDS_BYTES = 159744;
static_assert(attn_body::ATTN_LDS_BYTES <= RING_BYTES, "attention LDS");
static_assert(TBL_ROWTAB + ROWTAB_UNITS * 1024 <= LDS_BYTES, "LDS map");
constexpr int ATT_TAB_OFF = TBL_OFF;
static_assert(ATT_TAB_OFF + 4 * 640 * 4 + 16 <= LDS_BYTES, "LDS map");

#define GAS __attribute__((address_space(1)))
#define LAS __attribute__((address_space(3)))
typedef unsigned short bf16;
typedef unsigned v4u __attribute__((ext_vector_type(4)));
typedef float f32x4 __attribute__((ext_vector_type(4)));
typedef short bf16x8 __attribute__((ext_vector_type(8)));
typedef GAS unsigned gu32;
typedef GAS unsigned long long gu64;
#define RLX_AGENT __ATOMIC_RELAXED, __HIP_MEMORY_SCOPE_AGENT
#define LDS_WAIT() asm volatile("s_waitcnt lgkmcnt(0)" ::: "memory")
#define VM_WAIT() asm volatile("s_waitcnt vmcnt(0)" ::: "memory")
__device__ __forceinline__ unsigned long long rt() { return __builtin_amdgcn_s_memrealtime(); }
__device__ __forceinline__ unsigned f2bf(float f) { unsigned u = __builtin_bit_cast(unsigned, f); return (u + 0x7fffu + ((u >> 16) & 1u)) >> 16; }
__device__ __forceinline__ unsigned pk2(float lo, float hi) { return f2bf(lo) | (f2bf(hi) << 16); }

#define XB_TMO      128
#define XB_XCNT(j)  (256  + 64 * (j))
#define XB_XSUB(j)  (1280 + 64 * (j))
#define XB_XGEN(j)  (2304 + 64 * (j))
#define XB_TOP      3328
#define XB_TOPGEN   3392
#define XCD_BAR_WORDS 3456
#define XB_SPIN_CAP (1u << 18)

__device__ __forceinline__ unsigned xb_ld(unsigned* p)              { return __hip_atomic_load(p, __ATOMIC_RELAXED, __HIP_MEMORY_SCOPE_AGENT); }
__device__ __forceinline__ unsigned xb_add(unsigned* p, unsigned v) { return __hip_atomic_fetch_add(p, v, __ATOMIC_RELAXED, __HIP_MEMORY_SCOPE_AGENT); }
__device__ __forceinline__ unsigned xb_xcc_id() { return (unsigned)__builtin_amdgcn_s_getreg((3 << 11) | 20) & 0xFu; }
#define XB_SPIN(cond, bar) do { unsigned _sp = 0; while (cond) { __builtin_amdgcn_s_sleep(1); \
    if ((++_sp & 255u) == 0u) { if (xb_ld(&(bar)[XB_TMO])) break; if (_sp > XB_SPIN_CAP) { atomicAdd(&(bar)[XB_TMO], 1u); break; } } } } while (0)

struct XcdBarrier {
    unsigned* bar; unsigned x;
    volatile LAS unsigned* st;
};

__device__ __forceinline__ XcdBarrier xcd_barrier_post(unsigned* bar, volatile LAS unsigned* st) {
    XcdBarrier b; b.bar = bar; b.x = xb_xcc_id(); b.st = st;
    if (threadIdx.x == 0) (void)xb_add(&bar[XB_XCNT(b.x)], 1u);
    return b;
}
__device__ __forceinline__ void xcd_barrier_complete(unsigned* bar, unsigned x, unsigned& nloc, unsigned& nx) {
    const unsigned G = gridDim.x * gridDim.y * gridDim.z;
    unsigned sum, cnt, mine, sp = 0u;
    for (;;) {
        sum = 0u; cnt = 0u; mine = 0u;
#pragma unroll
        for (unsigned j = 0; j < 16; ++j) { const unsigned c = xb_ld(&bar[XB_XCNT(j)]); sum += c; cnt += (c > 0u) ? 1u : 0u; mine = (j == x) ? c : mine; }
        if (sum == G) break;
        __builtin_amdgcn_s_sleep(1);
        if ((++sp & 255u) == 0u) { if (xb_ld(&bar[XB_TMO])) break; if (sp > XB_SPIN_CAP) { atomicAdd(&bar[XB_TMO], 1u); break; } }
    }
    nloc = mine > 0u ? mine : 1u; nx = cnt > 0u ? cnt : 1u;
}

__device__ __forceinline__ void xcd_barrier(const XcdBarrier& b) {
    asm volatile("s_waitcnt vmcnt(0)" ::: "memory");
    __syncthreads();
    if (threadIdx.x == 0) {
        unsigned* bar = b.bar;
        __builtin_amdgcn_s_waitcnt(0);
        unsigned nloc = b.st[0], nx = b.st[1];
        if (nloc == 0u) { xcd_barrier_complete(bar, b.x, nloc, nx); b.st[0] = nloc; b.st[1] = nx; }
        const unsigned old = xb_add(&bar[XB_XSUB(b.x)], 1u);
        const unsigned gen = old / nloc;
        if (old + 1u == (gen + 1u) * nloc) {
            __builtin_amdgcn_fence(__ATOMIC_RELEASE, "agent");
            asm volatile("s_waitcnt vmcnt(0)" ::: "memory");
            const unsigned og = xb_add(&bar[XB_TOP], 1u);
            const unsigned tg = og / nx;
            if (og + 1u == (tg + 1u) * nx) xb_add(&bar[XB_TOPGEN], 1u);
            else XB_SPIN(xb_ld(&bar[XB_TOPGEN]) == tg, bar);
            __builtin_amdgcn_fence(__ATOMIC_ACQUIRE, "agent");
            xb_add(&bar[XB_XGEN(b.x)], 1u);
            asm volatile("s_waitcnt vmcnt(0)" ::: "memory");
        } else {
            XB_SPIN(xb_ld(&bar[XB_XGEN(b.x)]) == gen, bar);
            __builtin_amdgcn_fence(__ATOMIC_ACQUIRE, "agent");
            asm volatile("s_waitcnt vmcnt(0)" ::: "memory");
        }
    }
    __syncthreads();
}


struct Frame {
    LAS unsigned char* lds;
    volatile LAS unsigned* MISC;
    gu32* ctl;
    int tid, lane, wave;
    int vcu, G;
    const float* in[32]; float* out; unsigned char* ws;
};
#define WSP(T_, off) ((T_*)(F.ws + (off)))
__device__ __forceinline__ float wave_sum(float v) {
#pragma unroll
    for (int o = 1; o < 64; o <<= 1) v += __shfl_xor(v, o);
    return v;
}
__device__ __forceinline__ float bflo(unsigned w) { return __uint_as_float(w << 16); }
__device__ __forceinline__ float bfhi(unsigned w) { return __uint_as_float(w & 0xffff0000u); }
__device__ __forceinline__ float sigm_(float x) { return __builtin_amdgcn_rcpf(1.f + __builtin_amdgcn_exp2f(-LOG2E * x)); }

__device__ __forceinline__ void p0_transpose_item(const float* W, int K, int N, bf16* WT, int permHalf, LAS float* scr, int item, int lane) {
    const int nblk = N / 32, kb = item / nblk, nb = item % nblk, k0 = 64 * kb, n0 = 32 * nb;
    float tv[32];
#pragma unroll
    for (int i = 0; i < 32; ++i) tv[i] = W[(size_t)(k0 + 2 * i + (lane >> 5)) * N + n0 + (lane & 31)];
#pragma unroll
    for (int i = 0; i < 32; ++i) scr[(2 * i + (lane >> 5)) * 33 + (lane & 31)] = tv[i];
    LDS_WAIT(); asm volatile("" ::: "memory");
    const int c = lane & 7;
    int r0 = n0; if (permHalf) { const int bj = n0 / permHalf, idx = n0 % permHalf; r0 = 256 * (idx / 128) + 128 * bj + (idx % 128); }
#pragma unroll
    for (int j = 0; j < 4; ++j) { const int n = (lane >> 3) + 8 * j; const LAS float* s = scr + (8 * c) * 33 + n;
        v4u o; o.x = pk2(s[0 * 33], s[1 * 33]); o.y = pk2(s[2 * 33], s[3 * 33]); o.z = pk2(s[4 * 33], s[5 * 33]); o.w = pk2(s[6 * 33], s[7 * 33]);
        *(GAS v4u*)(WT + (size_t)(r0 + n) * K + k0 + 8 * c) = o; }
    LDS_WAIT(); asm volatile("" ::: "memory");
}
__device__ __forceinline__ void p0_prologue(Frame& F) {
    LAS float* scr = (LAS float*)(F.lds + RING_OFF + F.wave * 16384);
    const int gw = F.vcu * NWAVES + F.wave, NGW = F.G * NWAVES, lane = F.lane;
    constexpr int I_IN = 16 * 128, I_GLU = 8 * 32, I_PA = 8 * 32, I_PS = 8 * 32, I_OUT = 16 * 32, I_E1 = 32 * 512, I_E2 = 32 * 256, I_R = 256, I_SSM = 32, I_MISC = 1;
    constexpr int NITEMS = I_IN + I_GLU + I_PA + I_PS + I_OUT + I_E1 + I_E2 + I_R + I_SSM + I_MISC;
    for (int cb = F.vcu; cb < 96; cb += F.G) {
        const int j = cb * 64 + lane, k0 = F.wave * 128; const float* c = F.in[1]; const float* wa = F.in[2];
#pragma unroll
        for (int q = 0; q < 32; ++q) { const int idx = q * 64 + lane, kk = idx >> 4, b = idx & 15; const float v = c[b * 1024 + k0 + kk]; scr[idx] = v * sigm_(v); }
        LDS_WAIT(); asm volatile("" ::: "memory");
        float acc[16];
#pragma unroll
        for (int b = 0; b < 16; ++b) acc[b] = 0.f;
#pragma unroll 8
        for (int kk = 0; kk < 128; ++kk) { const float w = wa[(size_t)(k0 + kk) * 6144 + j];
#pragma unroll
            for (int q = 0; q < 4; ++q) { const f32x4 cv = *(const LAS f32x4*)(scr + kk * 16 + 4 * q); acc[4 * q] += w * cv.x; acc[4 * q + 1] += w * cv.y; acc[4 * q + 2] += w * cv.z; acc[4 * q + 3] += w * cv.w; } }
#pragma unroll
        for (int b = 0; b < 16; ++b) scr[2048 + b * 64 + lane] = acc[b];
        __syncthreads();
        float* mod = WSP(float, WS_MOD);
#pragma unroll
        for (int bb = 0; bb < 2; ++bb) { const int b = F.wave + 8 * bb; float sum = F.in[3][j];
#pragma unroll
            for (int w2 = 0; w2 < 8; ++w2) sum += ((const LAS float*)(F.lds + RING_OFF + w2 * 16384))[2048 + b * 64 + lane];
            mod[b * 6144 + j] = sum; }
        __syncthreads();
    }
    for (int it = gw; it < NITEMS; it += NGW) {
        int r = it;
        if (r < I_IN) { p0_transpose_item(F.in[5], 1024, 4096, WSP(bf16, WS_WIN), 0, scr, r, lane); continue; } r -= I_IN;
        if (r < I_GLU) { p0_transpose_item(F.in[20], 512, 1024, WSP(bf16, WS_WGLU), 512, scr, r, lane); continue; } r -= I_GLU;
        if (r < I_PA) { p0_transpose_item(F.in[21], 512, 1024, WSP(bf16, WS_WPA), 0, scr, r, lane); continue; } r -= I_PA;
        if (r < I_PS) { p0_transpose_item(F.in[22], 512, 1024, WSP(bf16, WS_WPS), 0, scr, r, lane); continue; } r -= I_PS;
        if (r < I_OUT) { p0_transpose_item(F.in[23], 1024, 1024, WSP(bf16, WS_WOUT), 0, scr, r, lane); continue; } r -= I_OUT;
        if (r < I_E1) { const int e = r / 512; p0_transpose_item(F.in[29] + (size_t)e * 1024 * 1024, 1024, 1024, WSP(bf16, WS_WE1) + (size_t)e * 1024 * 1024, 512, scr, r % 512, lane); continue; } r -= I_E1;
        if (r < I_E2) { const int e = r / 256; p0_transpose_item(F.in[30] + (size_t)e * 512 * 1024, 512, 1024, WSP(bf16, WS_WE2) + (size_t)e * 1024 * 512, 0, scr, r % 256, lane); continue; } r -= I_E2;
        if (r < I_R) {
            const int n = r; bf16* dst = WSP(bf16, WS_WR) + (size_t)n * 1024;
            for (int k = lane; k < 1024; k += 64) { float v = 0.f;
                if (n < 4) v = F.in[25][k * 4 + n]; else if (n < 36) { const int gq = (n - 4) >> 3, e = (n - 4) & 7; v = F.in[27][((size_t)gq * 1024 + k) * 8 + e]; }
                dst[k] = (bf16)f2bf(v); }
            continue; } r -= I_R;
        if (r < I_SSM) {
            const int g = r, p = lane;
            const float lr = fminf(F.in[12][g * 64 + p], -1e-4f), li = F.in[13][g * 64 + p], step = expf(F.in[14][g]);
            const float mag = expf(lr * step), ang = li * step, a_re = mag * cosf(ang), a_im = mag * sinf(ang);
            const float den = lr * lr + li * li, num_re = a_re - 1.0f, coef_re = (num_re * lr + a_im * li) / den, coef_im = (a_im * lr - num_re * li) / den;
            float* At = WSP(float, WS_TAB + TAB_A); float* AL = WSP(float, WS_TAB + TAB_AL);
            At[(g * 64 + p) * 2] = a_re; At[(g * 64 + p) * 2 + 1] = a_im;
            float zr = a_re, zi = a_im;
#pragma unroll
            for (int s = 0; s < 8; ++s) { const float nr = zr * zr - zi * zi, ni = 2.f * zr * zi; zr = nr; zi = ni; }
            AL[(g * 64 + p) * 2] = zr; AL[(g * 64 + p) * 2 + 1] = zi;
            bf16* BBt = WSP(bf16, WS_TAB + TAB_BBT); bf16* CCt = WSP(bf16, WS_TAB + TAB_CCT);
            const int n_re = ((p < 32) ? 0 : 64) + (p & 31), n_im = n_re + 32;
            for (int h = 0; h < 16; ++h) { const float br = F.in[15][(g * 64 + p) * 16 + h], bi = F.in[16][(g * 64 + p) * 16 + h];
                BBt[(g * 128 + n_re) * 16 + h] = (bf16)f2bf(coef_re * br - coef_im * bi); BBt[(g * 128 + n_im) * 16 + h] = (bf16)f2bf(coef_re * bi + coef_im * br);
                CCt[(g * 16 + h) * 128 + 2 * p] = (bf16)f2bf(F.in[17][(g * 16 + h) * 64 + p]); CCt[(g * 16 + h) * 128 + 2 * p + 1] = (bf16)f2bf(-F.in[18][(g * 16 + h) * 64 + p]); }
            continue; } r -= I_SSM;
        {
            float* tb = WSP(float, WS_TAB + TAB_BIAS); float* b31 = WSP(float, WS_TAB + TAB_B31); float* lamp = WSP(float, WS_TAB + TAB_LAM);
            const float* rb = F.in[6];
            for (int idx = lane; idx < 4 * attn_body::TABN; idx += 64) { const int h = idx / attn_body::TABN, d = idx % attn_body::TABN - 255; float v = 0.f;
                if (d < 0) v = -INFINITY;
                else if (d < 128) { int bk;
                    if (d < 16) bk = d; else { const float lr = logf((float)d / 16.f) / logf(8.f); bk = 16 + (int)(lr * 16.f); bk = bk > 31 ? 31 : bk; }
                    v = (rb[bk * 4 + h] - rb[31 * 4 + h]) * LOG2E; }
                tb[idx] = v; }
            if (lane < 4) b31[lane] = rb[31 * 4 + lane] * LOG2E;
            const float s1 = wave_sum(F.in[7][lane] * F.in[8][lane]), s2 = wave_sum(F.in[9][lane] * F.in[10][lane]);
            if (lane == 0) lamp[0] = expf(s1) - expf(s2) + LAMBDA_INIT;
        }
    }
}

template <bool XBF> __device__ __forceinline__ void ln_load_row(int lane, const void* xrow, f32x4 (&v)[4]) {
    if (XBF) { const GAS unsigned long long* xr = (const GAS unsigned long long*)xrow + lane;
#pragma unroll
        for (int j = 0; j < 4; ++j) { const unsigned long long w = xr[64 * j]; v[j].x = bflo((unsigned)w); v[j].y = bfhi((unsigned)w); v[j].z = bflo((unsigned)(w >> 32)); v[j].w = bfhi((unsigned)(w >> 32)); } }
    else { const GAS f32x4* xr = (const GAS f32x4*)xrow + lane;
#pragma unroll
        for (int j = 0; j < 4; ++j) v[j] = xr[64 * j]; }
}
__device__ __forceinline__ void ln_store_row(int lane, const f32x4 (&v)[4], const float* gv, const float* shift, const float* scale, bf16* orow) {
    float s = 0.f;
#pragma unroll
    for (int j = 0; j < 4; ++j) s += (v[j].x * v[j].x + v[j].y * v[j].y) + (v[j].z * v[j].z + v[j].w * v[j].w);
    const float rstd = 1.f / sqrtf(wave_sum(s) * (1.f / D) + NORM_EPS);
    GAS unsigned long long* o8 = (GAS unsigned long long*)orow + lane;
#pragma unroll
    for (int j = 0; j < 4; ++j) { const f32x4 g4 = ((const f32x4*)gv)[lane + 64 * j], sh = ((const f32x4*)shift)[lane + 64 * j], sc = ((const f32x4*)scale)[lane + 64 * j];
        const f32x4 h = v[j] * rstd * g4 * (sc + 1.f) + sh;
        o8[64 * j] = (unsigned long long)pk2(h.x, h.y) | ((unsigned long long)pk2(h.z, h.w) << 32); }
}
template <bool XBF> __device__ __forceinline__ void ln_phase(Frame& F, const void* x, const float* gv, int shift_off, int scale_off, bf16* out) {
    const int gw = F.vcu * NWAVES + F.wave, NGW = F.G * NWAVES; const float* mod = WSP(float, WS_MOD); const size_t xpitch = XBF ? (size_t)D * 2 : (size_t)D * 4;
    for (int m = gw; m < T; m += 2 * NGW) { const int m2 = m + NGW; f32x4 v0[4], v1[4];
        ln_load_row<XBF>(F.lane, (const char*)x + (size_t)m * xpitch, v0); if (m2 < T) ln_load_row<XBF>(F.lane, (const char*)x + (size_t)m2 * xpitch, v1);
        { const float* mb = mod + (size_t)(m >> 12) * 6144; ln_store_row(F.lane, v0, gv, mb + shift_off, mb + scale_off, out + (size_t)m * D); }
        if (m2 < T) { const float* mb = mod + (size_t)(m2 >> 12) * 6144; ln_store_row(F.lane, v1, gv, mb + shift_off, mb + scale_off, out + (size_t)m2 * D); } }
}
__device__ __forceinline__ void attn_combine_phase(Frame& F) {
    const int gw = F.vcu * NWAVES + F.wave, NGW = F.G * NWAVES, lane = F.lane;
    const bf16* Ov = WSP(bf16, WS_OV); bf16* ya = WSP(bf16, WS_YATTN);
    const float lam = WSP(float, WS_TAB + TAB_LAM)[0];
    const int h = lane >> 4, half = (lane >> 3) & 1, d0 = 8 * (lane & 7);
    float gsub[8];
#pragma unroll
    for (int i = 0; i < 8; ++i) gsub[i] = F.in[11][half * 64 + d0 + i] * (1.f - LAMBDA_INIT);
    for (int m0 = gw; m0 < T; m0 += 4 * NGW) {
        v4u av[4], bv[4];
#pragma unroll
        for (int q = 0; q < 4; ++q) { const int m = m0 + q * NGW; if (m < T) { av[q] = *(const GAS v4u*)(Ov + (size_t)m * 1024 + (h * 4 + half) * 64 + d0); bv[q] = *(const GAS v4u*)(Ov + (size_t)m * 1024 + (h * 4 + 2 + half) * 64 + d0); } }
#pragma unroll
        for (int q = 0; q < 4; ++q) { const int m = m0 + q * NGW; if (m < T) { const v4u a = av[q], b = bv[q];
        float o[8];
        o[0] = bflo(a.x) - lam * bflo(b.x); o[1] = bfhi(a.x) - lam * bfhi(b.x); o[2] = bflo(a.y) - lam * bflo(b.y); o[3] = bfhi(a.y) - lam * bfhi(b.y);
        o[4] = bflo(a.z) - lam * bflo(b.z); o[5] = bfhi(a.z) - lam * bfhi(b.z); o[6] = bflo(a.w) - lam * bflo(b.w); o[7] = bfhi(a.w) - lam * bfhi(b.w);
        float ss = 0.f;
#pragma unroll
        for (int i = 0; i < 8; ++i) ss += o[i] * o[i];
        ss += __shfl_xor(ss, 1); ss += __shfl_xor(ss, 2); ss += __shfl_xor(ss, 4); ss += __shfl_xor(ss, 8);
        const float rs = 1.f / sqrtf(ss * (1.f / 128.f) + SUBLN_EPS);
        v4u w; w.x = pk2(o[0] * rs * gsub[0], o[1] * rs * gsub[1]); w.y = pk2(o[2] * rs * gsub[2], o[3] * rs * gsub[3]); w.z = pk2(o[4] * rs * gsub[4], o[5] * rs * gsub[5]); w.w = pk2(o[6] * rs * gsub[6], o[7] * rs * gsub[7]);
        *(GAS v4u*)(ya + (size_t)m * 512 + h * 128 + half * 64 + d0) = w; } }
    }
}

typedef float f32x16 __attribute__((ext_vector_type(16)));
template <int PASS> __device__ __forceinline__ void ssm_phase(Frame& F) {
    const int lane = F.lane, w = F.wave, q = lane & 31, hf = lane >> 5;
    LAS unsigned char* xl = F.lds + RING_OFF + w * 8704;
    const bf16* QKVU = WSP(bf16, WS_QKVU); bf16* YS = WSP(bf16, WS_YSSM); float* endp = WSP(float, WS_SSMEND);
    const bf16* BBt = WSP(bf16, WS_TAB + TAB_BBT); const bf16* CCt = WSP(bf16, WS_TAB + TAB_CCT); const float* At = WSP(float, WS_TAB + TAB_A); const float* AL = WSP(float, WS_TAB + TAB_AL);
    for (int unit = F.vcu; unit < 512; unit += F.G) {
        const int b = unit >> 5, cp = (unit >> 2) & 7, go = unit & 3, g = go * 8 + w, cc = cp + 8 * hf;
        bf16x8 Bf[4];
#pragma unroll
        for (int j = 0; j < 4; ++j) Bf[j] = *(const GAS bf16x8*)(BBt + (size_t)(g * 128 + j * 32 + q) * 16 + 8 * hf);
        const float ar0 = At[(g * 64 + q) * 2], ai0 = At[(g * 64 + q) * 2 + 1], ar1 = At[(g * 64 + 32 + q) * 2], ai1 = At[(g * 64 + 32 + q) * 2 + 1];
        float xr0 = 0.f, xi0 = 0.f, xr1 = 0.f, xi1 = 0.f;
        bf16x8 Cf[4]; float dsk[4];
        if (PASS == 2) {
            const float lr0 = AL[(g * 64 + q) * 2], li0 = AL[(g * 64 + q) * 2 + 1], lr1 = AL[(g * 64 + 32 + q) * 2], li1 = AL[(g * 64 + 32 + q) * 2 + 1];
            const float* eb = endp + (size_t)((b * 32 + g) * 16) * 128;
            for (int j = 0; j < 15; ++j) if (j < cc) {
                const float e0r = eb[j * 128 + q * 2], e0i = eb[j * 128 + q * 2 + 1], e1r = eb[j * 128 + (q + 32) * 2], e1i = eb[j * 128 + (q + 32) * 2 + 1];
                const float n0r = lr0 * xr0 - li0 * xi0 + e0r, n0i = lr0 * xi0 + li0 * xr0 + e0i, n1r = lr1 * xr1 - li1 * xi1 + e1r, n1i = lr1 * xi1 + li1 * xr1 + e1i;
                xr0 = n0r; xi0 = n0i; xr1 = n1r; xi1 = n1i; }
#pragma unroll
            for (int kk = 0; kk < 4; ++kk) Cf[kk] = *(const GAS bf16x8*)(CCt + (size_t)(g * 16 + (lane & 15)) * 128 + 32 * kk + 8 * (lane >> 4));
#pragma unroll
            for (int i = 0; i < 4; ++i) dsk[i] = F.in[19][g * 16 + 4 * (lane >> 4) + i];
        }
        const int cs = (q >> 2) & 1, lt = (q >> 3) * 4 + (q & 3);
        const bf16* up = QKVU + ((size_t)b * SEQ + (cp + 8 * cs) * 256 + lt) * 2048 + 1536 + g * 16 + 8 * hf;
        bf16x8 Af = *(const GAS bf16x8*)up;
        for (int sb = 0; sb < 16; ++sb) {
            bf16x8 An = Af; if (sb < 15) An = *(const GAS bf16x8*)(up + (size_t)(sb + 1) * 16 * 2048);
            f32x16 z;
#pragma unroll
            for (int i = 0; i < 16; ++i) z[i] = 0.f;
            const f32x16 c0 = __builtin_amdgcn_mfma_f32_32x32x16_bf16(Af, Bf[0], z, 0, 0, 0), c1 = __builtin_amdgcn_mfma_f32_32x32x16_bf16(Af, Bf[1], z, 0, 0, 0),
                         c2 = __builtin_amdgcn_mfma_f32_32x32x16_bf16(Af, Bf[2], z, 0, 0, 0), c3 = __builtin_amdgcn_mfma_f32_32x32x16_bf16(Af, Bf[3], z, 0, 0, 0);
#pragma unroll
            for (int i = 0; i < 16; ++i) {
                const float n0r = fmaf(-ai0, xi0, fmaf(ar0, xr0, c0[i])), n0i = fmaf(ai0, xr0, fmaf(ar0, xi0, c1[i]));
                const float n1r = fmaf(-ai1, xi1, fmaf(ar1, xr1, c2[i])), n1i = fmaf(ai1, xr1, fmaf(ar1, xi1, c3[i]));
                xr0 = n0r; xi0 = n0i; xr1 = n1r; xi1 = n1i;
                if (PASS == 2) { LAS unsigned* dst = (LAS unsigned*)(xl + (16 * hf + i) * 272 + q * 4); dst[0] = pg8::cvt_pk_bf16(xr0, xi0); dst[32] = pg8::cvt_pk_bf16(xr1, xi1); }
            }
            if (PASS == 2) {
                LDS_WAIT(); asm volatile("" ::: "memory");
#pragma unroll
                for (int mt = 0; mt < 2; ++mt) {
                    f32x4 ya = (f32x4){0.f, 0.f, 0.f, 0.f};
#pragma unroll
                    for (int kk = 0; kk < 4; ++kk) { const bf16x8 Xf = *(const LAS bf16x8*)(xl + ((lane & 15) + 16 * mt) * 272 + 64 * kk + 16 * (lane >> 4));
                        ya = __builtin_amdgcn_mfma_f32_16x16x32_bf16(Cf[kk], Xf, ya, 0, 0, 0); }
                    const size_t trow = (size_t)b * SEQ + (cp + 8 * mt) * 256 + sb * 16 + (lane & 15);
                    const unsigned long long uw = *(const GAS unsigned long long*)(QKVU + trow * 2048 + 1536 + g * 16 + 4 * (lane >> 4));
                    float y[4]; y[0] = ya[0] + dsk[0] * bflo((unsigned)uw); y[1] = ya[1] + dsk[1] * bfhi((unsigned)uw); y[2] = ya[2] + dsk[2] * bflo((unsigned)(uw >> 32)); y[3] = ya[3] + dsk[3] * bfhi((unsigned)(uw >> 32));
#pragma unroll
                    for (int i = 0; i < 4; ++i) { const float v = y[i]; y[i] = v * sigm_(1.5957691216057308f * (v + 0.044715f * v * v * v)); }
                    *(GAS unsigned long long*)(YS + trow * 512 + g * 16 + 4 * (lane >> 4)) = (unsigned long long)pk2(y[0], y[1]) | ((unsigned long long)pk2(y[2], y[3]) << 32);
                }
                LDS_WAIT(); asm volatile("" ::: "memory");
            }
            Af = An;
        }
        if (PASS == 1) { float* e = endp + (size_t)(((b * 32 + g) * 16 + cc)) * 128; e[q * 2] = xr0; e[q * 2 + 1] = xi0; e[(q + 32) * 2] = xr1; e[(q + 32) * 2 + 1] = xi1; }
    }
}

__device__ __forceinline__ void routing_phase(Frame& F) {
    LAS int* hist = (LAS int*)(F.lds + RING_OFF); LAS int* base = hist + 32;
    const float* logits = WSP(float, WS_LOGITS); int* list = WSP(int, WS_LIST); int* tok_e = WSP(int, WS_TOK); int* tok_r = tok_e + 2 * T; float* tok_w = (float*)(tok_r + 2 * T);
    const int tid = F.tid;
    for (int chunk = F.vcu; chunk < T / 256; chunk += F.G) {
        if (tid < 64) hist[tid] = 0;
        __syncthreads();
        int e1 = 0, e2 = 0, r1 = 0, r2 = 0; float w1 = 0.f, w2 = 0.f; const int tok = chunk * 256 + tid;
        if (tid < 256) {
            const float* lp = logits + (size_t)tok * 64;
            float lg[4]; { const f32x4 v = *(const f32x4*)lp; lg[0] = v.x + F.in[26][0]; lg[1] = v.y + F.in[26][1]; lg[2] = v.z + F.in[26][2]; lg[3] = v.w + F.in[26][3]; }
            int grp = 0; float mx = lg[0];
#pragma unroll
            for (int j = 1; j < 4; ++j) if (lg[j] > mx) { mx = lg[j]; grp = j; }
            float den = 0.f;
#pragma unroll
            for (int j = 0; j < 4; ++j) den += expf(lg[j] - mx);
            const float pg = 1.f / den;
            float le[8]; { const f32x4 a = *(const f32x4*)(lp + 4 + grp * 8), b = *(const f32x4*)(lp + 8 + grp * 8); const float* br = F.in[28] + grp * 8;
                le[0] = a.x + br[0]; le[1] = a.y + br[1]; le[2] = a.z + br[2]; le[3] = a.w + br[3]; le[4] = b.x + br[4]; le[5] = b.y + br[5]; le[6] = b.z + br[6]; le[7] = b.w + br[7]; }
            int i1 = 0; float v1 = le[0];
#pragma unroll
            for (int j = 1; j < 8; ++j) if (le[j] > v1) { v1 = le[j]; i1 = j; }
            int i2 = -1; float v2 = -INFINITY;
#pragma unroll
            for (int j = 0; j < 8; ++j) if (j != i1 && (i2 < 0 || le[j] > v2)) { v2 = le[j]; i2 = j; }
            const float ex = expf(v2 - v1), s1 = 1.f / (1.f + ex);
            w1 = pg * s1; w2 = pg * (ex * s1); e1 = grp * 8 + i1; e2 = grp * 8 + i2;
            r1 = __hip_atomic_fetch_add(&hist[e1], 1, __ATOMIC_RELAXED, __HIP_MEMORY_SCOPE_WORKGROUP); r2 = __hip_atomic_fetch_add(&hist[e2], 1, __ATOMIC_RELAXED, __HIP_MEMORY_SCOPE_WORKGROUP);
        }
        __syncthreads();
        if (tid < 32) base[tid] = (int)__hip_atomic_fetch_add((unsigned*)(F.ctl + CW_CNT) + tid, (unsigned)hist[tid], __ATOMIC_RELAXED, __HIP_MEMORY_SCOPE_AGENT);
        __syncthreads();
        if (tid < 256) { r1 += base[e1]; r2 += base[e2];
            list[(size_t)e1 * T + r1] = tok; list[(size_t)e2 * T + r2] = tok;
            tok_e[2 * tok] = e1; tok_e[2 * tok + 1] = e2; tok_r[2 * tok] = r1; tok_r[2 * tok + 1] = r2; tok_w[2 * tok] = w1; tok_w[2 * tok + 1] = w2; }
        __syncthreads();
    }
}
__device__ __forceinline__ int expert_tables(Frame& F) {
    LAS int* cnt = (LAS int*)(F.lds + TBL_CNT); LAS int* tstart = (LAS int*)(F.lds + TBL_TSTART); LAS int* tile_e = (LAS int*)(F.lds + TBL_TILE_E);
    if (F.tid < 32) cnt[F.tid] = (int)__hip_atomic_load((unsigned*)(F.ctl + CW_CNT) + F.tid, __ATOMIC_RELAXED, __HIP_MEMORY_SCOPE_AGENT);
    __syncthreads();
    if (F.tid == 0) { int s = 0; for (int e = 0; e < 32; ++e) { tstart[e] = s; s += (cnt[e] + 255) >> 8; } tstart[32] = s > 544 ? 544 : s; }
    __syncthreads();
    const int MT = tstart[32];
    for (int t = F.tid; t < MT; t += NWAVES * 64) { int e = 0; while (e < 31 && tstart[e + 1] <= t) ++e; tile_e[t] = e; }
    __syncthreads();
    return MT;
}
__device__ __forceinline__ void final_phase(Frame& F) {
    (void)expert_tables(F);
    const LAS int* tstart = (const LAS int*)(F.lds + TBL_TSTART);
    const int gw = F.vcu * NWAVES + F.wave, NGW = F.G * NWAVES, lane = F.lane;
    const bf16* x1 = WSP(bf16, WS_X1); const bf16* ys = WSP(bf16, WS_YS); const float* mod = WSP(float, WS_MOD);
    const int* tok_e = WSP(int, WS_TOK); const int* tok_r = tok_e + 2 * T; const float* tok_w = (const float*)(tok_r + 2 * T);
    for (int m0 = gw; m0 < T; m0 += 2 * NGW) {
        f32x4 v[2][4]; float ssq[2];
#pragma unroll
        for (int q = 0; q < 2; ++q) { const int m = m0 + q * NGW; ssq[q] = 0.f; if (m < T) {
            const int e0 = tok_e[2 * m], e1 = tok_e[2 * m + 1]; const size_t p0 = ((size_t)tstart[e0] << 8) + tok_r[2 * m], p1 = ((size_t)tstart[e1] << 8) + tok_r[2 * m + 1];
            const float w0 = tok_w[2 * m], w1 = tok_w[2 * m + 1];
            const GAS unsigned long long* xr = (const GAS unsigned long long*)(x1 + (size_t)m * D) + lane; const f32x4* g2 = (const f32x4*)(mod + (size_t)(m >> 12) * 6144 + 5120) + lane;
            const GAS unsigned long long* y0 = (const GAS unsigned long long*)(ys + p0 * 1024) + lane; const GAS unsigned long long* y1 = (const GAS unsigned long long*)(ys + p1 * 1024) + lane;
#pragma unroll
            for (int j = 0; j < 4; ++j) { const unsigned long long a = y0[64 * j], b = y1[64 * j], xw = xr[64 * j]; const f32x4 gt = g2[64 * j]; f32x4 mo, xv;
                mo.x = w0 * bflo((unsigned)a) + w1 * bflo((unsigned)b); mo.y = w0 * bfhi((unsigned)a) + w1 * bfhi((unsigned)b);
                mo.z = w0 * bflo((unsigned)(a >> 32)) + w1 * bflo((unsigned)(b >> 32)); mo.w = w0 * bfhi((unsigned)(a >> 32)) + w1 * bfhi((unsigned)(b >> 32));
                xv.x = bflo((unsigned)xw); xv.y = bfhi((unsigned)xw); xv.z = bflo((unsigned)(xw >> 32)); xv.w = bfhi((unsigned)(xw >> 32));
                v[q][j] = xv + gt * mo; ssq[q] += (v[q][j].x * v[q][j].x + v[q][j].y * v[q][j].y) + (v[q][j].z * v[q][j].z + v[q][j].w * v[q][j].w); } } }
#pragma unroll
        for (int q = 0; q < 2; ++q) { const int m = m0 + q * NGW; if (m < T) {
            const float rstd = 1.f / sqrtf(wave_sum(ssq[q]) * (1.f / D) + NORM_EPS);
            GAS f32x4* o = (GAS f32x4*)(F.out + (size_t)m * D) + lane;
#pragma unroll
            for (int j = 0; j < 4; ++j) o[64 * j] = v[q][j] * rstd * ((const f32x4*)F.in[31])[lane + 64 * j]; } }
    }
}

struct Args { const float* in[32]; float* out; unsigned char* ws; int ph_lo, ph_hi; };
__global__ void __launch_bounds__(NWAVES * 64, 2) fwd(Args args) {
    extern __shared__ __attribute__((aligned(16))) unsigned char lds[];
    Frame F;
    F.lds = (LAS unsigned char*)lds;
    F.MISC = (volatile LAS unsigned*)(F.lds + MISC_OFF);
    F.tid = threadIdx.x; F.lane = F.tid & 63; F.wave = __builtin_amdgcn_readfirstlane(F.tid >> 6);
    F.G = gridDim.x; { const int bx = blockIdx.x; F.vcu = (F.G % 8 == 0) ? (bx % 8) * (F.G / 8) + bx / 8 : bx; }
#pragma unroll
    for (int i = 0; i < 32; ++i) F.in[i] = args.in[i];
    F.out = args.out; F.ws = args.ws; F.ctl = (gu32*)(args.ws + WS_CTL);
    for (int u = F.tid; u < 128; u += NWAVES * 64) ((LAS unsigned*)(F.lds + LDSCTL_OFF))[u] = 0u;
    __syncthreads();
    XcdBarrier bar; bar.bar = (unsigned*)(F.ctl + CW_BAR); bar.x = 0; bar.st = nullptr;
#if !MK_PER_PHASE
    bar = xcd_barrier_post((unsigned*)(F.ctl + CW_BAR), F.MISC + 8);
#define GRID_BAR() xcd_barrier(bar)
#else
#define GRID_BAR() do { } while (0)
#endif
    const int lo = args.ph_lo, hi = args.ph_hi;
#ifndef PHMASK
#define PHMASK 0x7fff
#endif
#define IN(k) (((PHMASK >> (k)) & 1) && lo <= (k) && (k) < hi)
#define SEAM(k) do { if ((k) != 6 && IN(k) && IN((k) + 1)) GRID_BAR(); } while (0)
#ifndef PROBE_REPEAT
#define PROBE_REPEAT 0
#endif
#define PHASE(k, ...) do { if (IN(k)) { { __VA_ARGS__ } if ((PROBE_REPEAT >> (k)) & 1) { __VA_ARGS__ } } } while (0)
    using pg8::bf16_t;
    PHASE(0,  p0_prologue(F); ); SEAM(0);
    PHASE(1,  ln_phase<false>(F, F.in[0], F.in[4], 0, 1024, WSP(bf16, WS_H1)); ); SEAM(1);
    PHASE(2,  pg8::Gemm g{WSP(bf16_t, WS_H1), WSP(bf16_t, WS_WIN), 1024}; pg8::StaticOrder S; S.init(T, 4096, F.G, (int)blockIdx.x);
        pg8::EpiInProj E{WSP(bf16_t, WS_QKVU), WSP(bf16_t, WS_GATES), 0.125f * LOG2E};
        pg8::gemm_phase<pg8::EpiInProj, pg8::StaticOrder, true>(F.lds + RING_OFF, g, S, E); ); SEAM(2);
    PHASE(3,
        ssm_phase<1>(F);
#if defined(PROBE_SSM1)
        ssm_phase<1>(F);
#endif
        __syncthreads();
        { LAS float* tabs = (LAS float*)(F.lds + ATT_TAB_OFF); const float* tb = WSP(float, WS_TAB + TAB_BIAS); const float* b31g = WSP(float, WS_TAB + TAB_B31);
          for (int i = F.tid; i < 4 * attn_body::TABN; i += NWAVES * 64) tabs[i] = tb[i];
          if (F.tid < 4) tabs[4 * attn_body::TABN + F.tid] = b31g[F.tid]; }
        __syncthreads();
        const attn_body::AttnTensors AT{(const attn_body::bf16*)WSP(bf16, WS_QKVU), (attn_body::bf16*)WSP(bf16, WS_OV), (attn_body::lds_fptr)(F.lds + ATT_TAB_OFF), (attn_body::lds_fptr)(F.lds + ATT_TAB_OFF) + 4 * attn_body::TABN};
        const attn_body::StaticOrder S((int)F.G, F.vcu);
        attn_body::attn_phase<attn_body::StaticOrder>((char*)lds + RING_OFF, AT, S);
    ); SEAM(3);
    PHASE(4,  ssm_phase<2>(F); attn_combine_phase(F); ); SEAM(4);
    PHASE(5,  pg8::Gemm g{WSP(bf16_t, WS_YSSM), WSP(bf16_t, WS_WGLU), 512}; pg8::StaticOrder S; S.init(T, 1024, F.G, (int)blockIdx.x);
        pg8::EpiGate<0> E{WSP(bf16_t, WS_S), 512};
        pg8::gemm_phase<pg8::EpiGate<0>, pg8::StaticOrder, true>(F.lds + RING_OFF, g, S, E); ); SEAM(5);
    PHASE(6,  pg8::Gemm g{WSP(bf16_t, WS_YATTN), WSP(bf16_t, WS_WPA), 512}; pg8::ChainOrder S; S.so.init(T, 1024, F.G, (int)blockIdx.x);
        S.arow_off = (unsigned)((WS_S - WS_YATTN) / 1024); S.bt_off = (int)((WS_WPS - WS_WPA) / (256 * 512 * 2));
        pg8::EpiMerge E{WSP(bf16_t, WS_GATES), WSP(bf16_t, WS_MERGED)};
        pg8::gemm_phase<pg8::EpiMerge, pg8::ChainOrder, true>(F.lds + RING_OFF, g, S, E); ); SEAM(6);
    SEAM(7);
    PHASE(8,  pg8::Gemm g{WSP(bf16_t, WS_MERGED), WSP(bf16_t, WS_WOUT), 1024}; pg8::StaticOrder S; S.init(T, 1024, F.G, (int)blockIdx.x);
        pg8::EpiResid E{F.in[0], WSP(float, WS_MOD), WSP(bf16_t, WS_X1)};
        pg8::gemm_phase<pg8::EpiResid, pg8::StaticOrder, true>(F.lds + RING_OFF, g, S, E); ); SEAM(8);
    PHASE(9,  ln_phase<true>(F, WSP(bf16, WS_X1), F.in[24], 3072, 4096, WSP(bf16, WS_H2)); ); SEAM(9);
    PHASE(10,  pg8::Gemm g{WSP(bf16_t, WS_H2), WSP(bf16_t, WS_WR), 1024}; pg8::StaticOrder S; S.init(T, 256, F.G, (int)blockIdx.x);
        pg8::EpiRouter E{WSP(float, WS_LOGITS)};
        pg8::gemm_phase<pg8::EpiRouter, pg8::StaticOrder, true>(F.lds + RING_OFF, g, S, E); ); SEAM(10);
    PHASE(11,  routing_phase(F); ); SEAM(11);
    PHASE(12,  const int MT = expert_tables(F);
        LAS int* rowtab = (LAS int*)(F.lds + TBL_ROWTAB); const LAS int* tile_e = (const LAS int*)(F.lds + TBL_TILE_E); const LAS int* tstart = (const LAS int*)(F.lds + TBL_TSTART); const LAS int* cnt = (const LAS int*)(F.lds + TBL_CNT);
        const int* list = WSP(int, WS_LIST);
        for (int ui = 0; ui < ROWTAB_UNITS; ++ui) { const int L = ui * F.G + F.vcu; if (L >= MT * 4) break;
            if (F.tid < 256) { const int mt = L >> 2, e = tile_e[mt], rank = ((mt - tstart[e]) << 8) + F.tid; rowtab[ui * 256 + F.tid] = rank < cnt[e] ? list[(size_t)e * T + rank] : 0; } }
        __syncthreads();
        pg8::Gemm g{WSP(bf16_t, WS_H2), WSP(bf16_t, WS_WE1), 1024}; pg8::ExpertOrder S{tile_e, rowtab, MT, F.G, F.vcu, true};
        pg8::EpiGate<1> E{WSP(bf16_t, WS_ACT), 512};
        pg8::gemm_phase<pg8::EpiGate<1>, pg8::ExpertOrder, true>(F.lds + RING_OFF, g, S, E); ); SEAM(12);
    PHASE(13,  const int MT = expert_tables(F);
        const LAS int* tile_e = (const LAS int*)(F.lds + TBL_TILE_E);
        pg8::Gemm g{WSP(bf16_t, WS_ACT), WSP(bf16_t, WS_WE2), 512}; pg8::ExpertOrder S{tile_e, nullptr, MT, F.G, F.vcu, false};
        pg8::EpiPlain E{WSP(bf16_t, WS_YS), 1024};
        pg8::gemm_phase<pg8::EpiPlain, pg8::ExpertOrder, true>(F.lds + RING_OFF, g, S, E); ); SEAM(13);
    PHASE(14,  final_phase(F); );
#undef IN
#undef SEAM
#undef PHASE
}

extern "C" void kernel_launch(void* const* d_in, const int* in_sizes, int n_in, void* d_out, int out_size, void* d_ws, size_t ws_size, hipStream_t stream) {
    static int grid = 0;
    if (grid == 0) {
        if (n_in != 32 || out_size != T * D || ws_size < WS_END) { fprintf(stderr, "kernel_launch: unexpected shapes (n_in %d out %d ws %zu)\n", n_in, out_size, ws_size); grid = -1; return; }
        int dev = 0, cus = 0, per_cu = 0;
        if (hipGetDevice(&dev) != hipSuccess || hipDeviceGetAttribute(&cus, hipDeviceAttributeMultiprocessorCount, dev) != hipSuccess) { grid = -1; return; }
        if (hipFuncSetAttribute((const void*)fwd, hipFuncAttributeMaxDynamicSharedMemorySize, LDS_BYTES) != hipSuccess) { fprintf(stderr, "kernel_launch: hipFuncSetAttribute failed\n"); grid = -1; return; }
        if (hipOccupancyMaxActiveBlocksPerMultiprocessor(&per_cu, (const void*)fwd, NWAVES * 64, LDS_BYTES) != hipSuccess || per_cu < 1) fprintf(stderr, "kernel_launch: occupancy query reports %d\n", per_cu);
        (void)hipGetLastError();
        grid = cus;
    }
    if (grid < 0) return;
    if (hipMemsetAsync((char*)d_ws + WS_CTL, 0, CTL_ZERO_BYTES, stream) != hipSuccess) return;
    Args a{};
    for (int i = 0; i < 32; ++i) a.in[i] = (const float*)d_in[i];
    a.out = (float*)d_out; a.ws = (unsigned char*)d_ws;
#if MK_PER_PHASE
    for (int p = 0; p < NPH; ++p) { a.ph_lo = p; a.ph_hi = p + 1; hipLaunchKernelGGL(fwd, dim3(grid), dim3(NWAVES * 64), LDS_BYTES, stream, a); }
#else
    a.ph_lo = 0; a.ph_hi = NPH; hipLaunchKernelGGL(fwd, dim3(grid), dim3(NWAVES * 64), LDS_BYTES, stream, a);
#endif
}
```
